# Optimizing an MI355X kernel written in HIP

```python
import jax, jax.numpy as jnp
from jax import lax
import numpy as np

D_MODEL = 1024
BATCH = 8
SEQ = 4096
DEPTH = 1

N_Q_HEADS = 16
N_KV_HEADS = 4
HEAD_DIM = 64
ROT_DIM = HEAD_DIM // 4
ROPE_THETA = 500000.0
WINDOW = 128
BLOCK = 128
CONV_DIM = D_MODEL
CONV_WIDTH = 31
D_FF = 4 * D_MODEL
N_BRANCH = 2
EPS = 1e-6
Q_W = N_Q_HEADS * HEAD_DIM
KV_W = N_KV_HEADS * HEAD_DIM
GATE_W = N_BRANCH * D_MODEL
IN_W = Q_W + 2 * KV_W + 2 * CONV_DIM + GATE_W

kernel_name = "hybrid_swa_sink_conformer_conv_gated_block"


def _rmsnorm(x, g):
    xf = x.astype(jnp.float32)
    y = xf * lax.rsqrt(jnp.mean(xf * xf, axis=-1, keepdims=True) + EPS)
    return (y * g.astype(jnp.float32)).astype(x.dtype)


def _layernorm(x, g, b):
    xf = x.astype(jnp.float32)
    mu = jnp.mean(xf, axis=-1, keepdims=True)
    var = jnp.mean(jnp.square(xf - mu), axis=-1, keepdims=True)
    y = (xf - mu) * lax.rsqrt(var + EPS)
    return (y * g.astype(jnp.float32) + b.astype(jnp.float32)).astype(x.dtype)


def _partial_rope(t, positions):
    half = ROT_DIM // 2
    inv_freq = 1.0 / (jnp.float32(ROPE_THETA) ** (jnp.arange(0, ROT_DIM, 2, dtype=jnp.float32) / ROT_DIM))
    ang = positions.astype(jnp.float32)[:, None] * inv_freq[None, :]
    cos = jnp.cos(ang)[None, :, None, :]
    sin = jnp.sin(ang)[None, :, None, :]
    tr = t[..., :ROT_DIM].astype(jnp.float32)
    t1, t2 = tr[..., :half], tr[..., half:]
    rot = jnp.concatenate([t1 * cos - t2 * sin, t2 * cos + t1 * sin], axis=-1)
    return jnp.concatenate([rot.astype(t.dtype), t[..., ROT_DIM:]], axis=-1)


def _band(t):
    b, s, h, d = t.shape
    tb = t.reshape(b, s // BLOCK, BLOCK, h, d)
    prev = jnp.pad(tb[:, :-1], ((0, 0), (1, 0), (0, 0), (0, 0), (0, 0)))
    return jnp.concatenate([prev, tb], axis=2)


def _sliding_window_sink_attention(q, k, v, sinks):
    b, s, _, d = q.shape
    nb = s // BLOCK
    grp = N_Q_HEADS // N_KV_HEADS
    qb = q.reshape(b, nb, BLOCK, N_KV_HEADS, grp, d)
    kb = _band(k)
    vb = _band(v)
    scores = jnp.einsum("bnqkgd,bnskd->bnkgqs", qb, kb).astype(jnp.float32) * (HEAD_DIM ** -0.5)
    i = jnp.arange(BLOCK)[:, None]
    j = jnp.arange(2 * BLOCK)[None, :]
    rel = i + BLOCK - j
    kpos = jnp.arange(nb)[:, None, None] * BLOCK - BLOCK + j[None]
    valid = (rel >= 0) & (rel < WINDOW) & (kpos >= 0)
    scores = jnp.where(valid[None, :, None, None], scores, -jnp.inf)
    sink = jnp.broadcast_to(
        sinks.astype(jnp.float32).reshape(N_KV_HEADS, grp)[None, None, :, :, None, None],
        scores.shape[:-1] + (1,))
    probs = jax.nn.softmax(jnp.concatenate([scores, sink], axis=-1), axis=-1)[..., :-1]
    out = jnp.einsum("bnkgqs,bnskd->bnqkgd", probs.astype(v.dtype), vb)
    return out.reshape(b, s, N_Q_HEADS * d)


def _conformer_conv(u, conv_w, conv_b, norm_g, norm_b, w_conv_out):
    a, gt = jnp.split(u, 2, axis=-1)
    glu = a * jax.nn.sigmoid(gt)
    y = lax.conv_general_dilated(
        glu, conv_w[:, None, :].astype(glu.dtype), window_strides=(1,),
        padding=[(CONV_WIDTH - 1, 0)], dimension_numbers=("NWC", "WIO", "NWC"),
        feature_group_count=CONV_DIM) + conv_b
    y = jax.nn.silu(_layernorm(y, norm_g, norm_b))
    return y @ w_conv_out


def setup_inputs(seed: int = 0) -> dict:
    key = jax.random.key(seed)
    ks = jax.random.split(key, 20)
    f32 = jnp.float32
    n = lambda k, shape, scale: jax.random.normal(k, shape, f32) * scale
    L = DEPTH
    return {
        "x": n(ks[0], (BATCH, SEQ, D_MODEL), 1.0),
        "norm1_g": 1.0 + n(ks[1], (L, D_MODEL), 0.02),
        "w_in": n(ks[2], (L, D_MODEL, IN_W), D_MODEL ** -0.5),
        "gate_b": n(ks[3], (L, GATE_W), 0.02),
        "q_norm_g": 1.0 + n(ks[4], (L, HEAD_DIM), 0.02),
        "k_norm_g": 1.0 + n(ks[5], (L, HEAD_DIM), 0.02),
        "sinks": n(ks[6], (L, N_Q_HEADS), 0.5),
        "w_attn_out": n(ks[7], (L, Q_W, D_MODEL), Q_W ** -0.5),
        "conv_w": n(ks[8], (L, CONV_WIDTH, CONV_DIM), CONV_WIDTH ** -0.5),
        "conv_b": n(ks[9], (L, CONV_DIM), 0.02),
        "conv_norm_g": 1.0 + n(ks[10], (L, CONV_DIM), 0.02),
        "conv_norm_b": n(ks[11], (L, CONV_DIM), 0.02),
        "w_conv_out": n(ks[12], (L, CONV_DIM, D_MODEL), CONV_DIM ** -0.5),
        "w_out": n(ks[13], (L, D_MODEL, D_MODEL), D_MODEL ** -0.5),
        "norm2_g": 1.0 + n(ks[14], (L, D_MODEL), 0.02),
        "w_up": n(ks[15], (L, D_MODEL, D_FF), D_MODEL ** -0.5),
        "w_down": n(ks[16], (L, D_FF, D_MODEL), D_FF ** -0.5),
    }


def reference(x, norm1_g, w_in, gate_b, q_norm_g, k_norm_g, sinks, w_attn_out,
              conv_w, conv_b, conv_norm_g, conv_norm_b, w_conv_out, w_out,
              norm2_g, w_up, w_down):
    b, s, _ = x.shape
    positions = jnp.arange(s, dtype=jnp.int32)
    splits = np.cumsum([Q_W, KV_W, KV_W, 2 * CONV_DIM]).tolist()
    for l in range(DEPTH):
        h = _rmsnorm(x, norm1_g[l])
        proj = h @ w_in[l]
        q, k, v, conv_in, gate_logits = jnp.split(proj, splits, axis=-1)
        q = q.reshape(b, s, N_Q_HEADS, HEAD_DIM)
        k = k.reshape(b, s, N_KV_HEADS, HEAD_DIM)
        v = v.reshape(b, s, N_KV_HEADS, HEAD_DIM)
        q = _partial_rope(_rmsnorm(q, q_norm_g[l]), positions)
        k = _partial_rope(_rmsnorm(k, k_norm_g[l]), positions)
        y_attn = _sliding_window_sink_attention(q, k, v, sinks[l]) @ w_attn_out[l]
        y_conv = _conformer_conv(conv_in, conv_w[l], conv_b[l], conv_norm_g[l],
                                 conv_norm_b[l], w_conv_out[l])
        gates = jax.nn.sigmoid(gate_logits + gate_b[l]).reshape(b, s, N_BRANCH, D_MODEL)
        merged = gates[:, :, 0] * y_attn + gates[:, :, 1] * y_conv
        x = x + merged @ w_out[l]
        hn = _rmsnorm(x, norm2_g[l])
        x = x + jnp.square(jax.nn.relu(hn @ w_up[l])) @ w_down[l]
    return x
```

```cpp
#include <hip/hip_runtime.h>
#include <hip/hip_cooperative_groups.h>
#include <cstdio>
#include <cstdint>
namespace cg = cooperative_groups;
namespace pg8 {
#define PG8_LAS __attribute__((address_space(3)))
typedef unsigned short bf16_t;
typedef short bf16x8 __attribute__((ext_vector_type(8)));
typedef float f32x4 __attribute__((ext_vector_type(4)));
typedef unsigned u32x4 __attribute__((ext_vector_type(4)));
constexpr int BM = 256, BK = 64, HALF = 128, HTB = HALF * BK * 2  , STAGE_BYTES = 8 * HTB, NXCD = 8, WGM = 4;

__host__ __device__ __forceinline__ int lds_byte(int r, int c) { const int st = (r >> 4) * 2 + (c >> 5), rr = r & 15, cc = c & 31, ob = rr * 64 + cc * 2; return st * 1024 + (ob ^ (((ob >> 9) & 1) << 5)); }
__host__ __device__ __forceinline__ void stage_rc(int b, int& R, int& C) { const int st = b / 1024, sb = b % 1024, swz = sb ^ (((sb >> 9) & 1) << 5); R = (st >> 1) * 16 + swz / 64; C = (st & 1) * 32 + (swz % 64) / 2; }
__host__ __device__ __forceinline__ int perm32(int rho) { const int n = rho >> 4, i = rho & 15; return 8 * (i >> 2) + 4 * n + (i & 3); }

struct Unit { int pm, pn; };
struct Gemm { const bf16_t* A; const bf16_t* Bt; int M, N, K; };

struct StaticOrder {
    int nM, nN, nwg, G, c, wgm;
    __host__ __device__ void init(int M, int N, int G_, int c_, int wgm_ = WGM) { nM = M / BM; nN = N / BM; nwg = nM * nN; G = G_; c = c_; wgm = wgm_; }
    __host__ __device__ bool next(int i, Unit& u) const {
        const long L = (long)i * G + c; if (L >= nwg) return false;
        int wgid = (int)L; { const int q = nwg / NXCD, r = nwg % NXCD, xcd = wgid % NXCD, off = wgid / NXCD; wgid = (xcd < r ? xcd * (q + 1) : r * (q + 1) + (xcd - r) * q) + off; }
        const int nig = wgm * nN, gid = wgid / nig, fm = gid * wgm, gsz = (nM - fm) < wgm ? (nM - fm) : wgm;
        u.pm = fm + ((wgid % nig) % gsz); u.pn = (wgid % nig) / gsz; return true;
    }
    __device__ __forceinline__ void a_ready(const Unit&) const {}
    __device__ __forceinline__ void done(const Unit&) const {}
};

typedef float cvt_f32x2 __attribute__((ext_vector_type(2))); typedef __bf16 cvt_bf16x2 __attribute__((ext_vector_type(2)));
__device__ __forceinline__ unsigned cvt_pk_bf16(float lo, float hi) { cvt_f32x2 v = {lo, hi}; cvt_bf16x2 b = __builtin_convertvector(v, cvt_bf16x2); return __builtin_bit_cast(unsigned, b); }
typedef float f32x2 __attribute__((ext_vector_type(2)));
__device__ __forceinline__ float sigm(float x) { return __builtin_amdgcn_rcpf(1.f + __builtin_amdgcn_exp2f(-1.4426950408889634f * x)); }
__device__ __forceinline__ f32x4 sigm4(f32x4 v) { return (f32x4){sigm(v[0]), sigm(v[1]), sigm(v[2]), sigm(v[3])}; }
__device__ __forceinline__ u32x4 pack8(f32x4 a, f32x4 b) { u32x4 w; w.x = cvt_pk_bf16(a[0], a[1]); w.y = cvt_pk_bf16(a[2], a[3]); w.z = cvt_pk_bf16(b[0], b[1]); w.w = cvt_pk_bf16(b[2], b[3]); return w; }
__device__ __forceinline__ void unpack8(u32x4 w, f32x4& a, f32x4& b) {
    a = (f32x4){__uint_as_float(w.x << 16), __uint_as_float(w.x & 0xffff0000u), __uint_as_float(w.y << 16), __uint_as_float(w.y & 0xffff0000u)};
    b = (f32x4){__uint_as_float(w.z << 16), __uint_as_float(w.z & 0xffff0000u), __uint_as_float(w.w << 16), __uint_as_float(w.w & 0xffff0000u)}; }
__device__ __forceinline__ f32x4 shx4(f32x4 v, int m) { return (f32x4){__shfl_xor(v[0], m), __shfl_xor(v[1], m), __shfl_xor(v[2], m), __shfl_xor(v[3], m)}; }
__device__ __forceinline__ float hsum4(f32x4 v) { return (v[0] + v[1]) + (v[2] + v[3]); }
__device__ __forceinline__ void st_nt(bf16_t* p, u32x4 v) { __builtin_nontemporal_store(v, (u32x4*)p); }
__device__ __forceinline__ void st_nt(float* p, f32x4 v) { __builtin_nontemporal_store(v, (f32x4*)p); }

struct EpiInProj {
    static constexpr bool PERM = true, AFTER_DRAIN = false;
    bf16_t* QKV; bf16_t* GLU; bf16_t* G; const float* gate_b; const float* qg; const float* kg; const float* cs;
    __device__ __forceinline__ void operator()(const f32x4 (&acc)[2][2][4][2], const Unit& u, int wr, int wc, int fr, int fq) const {
        const int row0 = u.pm * BM + wr * 64 + fr;
        if (u.pn < 6) {
            const bool normed = u.pn < 5;
            const float qs = (u.pn < 4) ? 0.125f * 1.4426950408889634f : 1.f;
            const float* gsrc = (u.pn < 4) ? qg : kg;
            f32x4 gv[2][2];
#pragma unroll
            for (int bj = 0; bj < 2; ++bj)
#pragma unroll
                for (int n = 0; n < 2; ++n) gv[bj][n] = *(const f32x4*)(gsrc + 32 * bj + 8 * fq + 4 * n) * qs;
            const float sgn = (fq == 0) ? -1.f : 1.f;
            const int col = u.pn * 256 + wc * 64 + 8 * fq;
#pragma unroll
            for (int ai = 0; ai < 2; ++ai)
#pragma unroll
                for (int m = 0; m < 4; ++m) {
                    const int row = row0 + ai * HALF + m * 16;
                    f32x4 v00 = acc[ai][0][m][0], v01 = acc[ai][0][m][1], v10 = acc[ai][1][m][0], v11 = acc[ai][1][m][1];
                    if (normed) {
                        float ss = hsum4(v00 * v00) + hsum4(v01 * v01) + hsum4(v10 * v10) + hsum4(v11 * v11);
                        ss += __shfl_xor(ss, 16); ss += __shfl_xor(ss, 32);
                        const float rs = __builtin_amdgcn_rsqf(ss * (1.f / 64.f) + 1e-6f);
                        v00 = v00 * rs * gv[0][0]; v01 = v01 * rs * gv[0][1]; v10 = v10 * rs * gv[1][0]; v11 = v11 * rs * gv[1][1];
                        const f32x4* t = (const f32x4*)(cs + (size_t)(row & 4095) * 16);
                        const f32x4 c0 = t[0], c1 = t[1], s0 = t[2], s1 = t[3];
                        const f32x4 p0 = shx4(v00, 16), p1 = shx4(v01, 16);
                        const f32x4 r0 = v00 * c0 + p0 * s0 * sgn, r1 = v01 * c1 + p1 * s1 * sgn;
                        if (fq < 2) { v00 = r0; v01 = r1; }
                    }
                    bf16_t* rowp = QKV + (size_t)row * 1536 + col;
                    st_nt(rowp, pack8(v00, v01));
                    st_nt(rowp + 32, pack8(v10, v11));
                }
        } else if (u.pn < 14) {
            const int col = (u.pn - 6) * 128 + wc * 32 + 8 * fq;
#pragma unroll
            for (int ai = 0; ai < 2; ++ai)
#pragma unroll
                for (int m = 0; m < 4; ++m) {
                    const int row = row0 + ai * HALF + m * 16;
                    const f32x4 a0 = acc[ai][0][m][0] * sigm4(acc[ai][1][m][0]), a1 = acc[ai][0][m][1] * sigm4(acc[ai][1][m][1]);
                    st_nt(GLU + (size_t)row * 1024 + col, pack8(a0, a1));
                }
        } else {
            const int col = (u.pn - 14) * 256 + wc * 32 + 8 * fq;
            f32x4 bv[2][2];
#pragma unroll
            for (int bj = 0; bj < 2; ++bj)
#pragma unroll
                for (int n = 0; n < 2; ++n) bv[bj][n] = *(const f32x4*)(gate_b + col + bj * HALF + 4 * n);
#pragma unroll
            for (int ai = 0; ai < 2; ++ai)
#pragma unroll
                for (int m = 0; m < 4; ++m) {
                    const int row = row0 + ai * HALF + m * 16;
#pragma unroll
                    for (int bj = 0; bj < 2; ++bj)
                        st_nt(G + (size_t)row * 2048 + col + bj * HALF, pack8(sigm4(acc[ai][bj][m][0] + bv[bj][0]), sigm4(acc[ai][bj][m][1] + bv[bj][1])));
                }
        }
    }
};
struct EpiMerge {
    static constexpr bool PERM = true, AFTER_DRAIN = false;
    const bf16_t* Gt; bf16_t* Out;
    __device__ __forceinline__ void mid(f32x4 (&acc)[2][2][4][2], const Unit& u, int wr, int wc, int fr, int fq) const {
        int z; asm volatile("v_mov_b32 %0, 0" : "=v"(z));
        const int row0 = u.pm * BM + wr * 64 + fr + z, col = u.pn * BM + wc * 32 + 8 * fq;
#pragma unroll
        for (int ai = 0; ai < 2; ++ai)
#pragma unroll
            for (int m = 0; m < 4; ++m) {
                const int row = row0 + ai * HALF + m * 16;
#pragma unroll
                for (int bj = 0; bj < 2; ++bj) {
                    const bf16_t* gp = Gt + (size_t)row * 2048 + col + bj * HALF;
                    f32x4 a0, a1, b0, b1; unpack8(*(const u32x4*)gp, a0, a1); unpack8(*(const u32x4*)(gp + 1024), b0, b1);
#pragma unroll
                    for (int e = 0; e < 4; ++e) { acc[ai][bj][m][0][e] *= a0[e] * __builtin_amdgcn_rcpf(b0[e]); acc[ai][bj][m][1][e] *= a1[e] * __builtin_amdgcn_rcpf(b1[e]); }
                }
                asm volatile("" ::: "memory");
            }
    }
    __device__ __forceinline__ void operator()(const f32x4 (&acc)[2][2][4][2], const Unit& u, int wr, int wc, int fr, int fq) const {
        const int row0 = u.pm * BM + wr * 64 + fr, col = u.pn * BM + wc * 32 + 8 * fq;
#pragma unroll
        for (int ai = 0; ai < 2; ++ai)
#pragma unroll
            for (int m = 0; m < 4; ++m) {
                const int row = row0 + ai * HALF + m * 16;
#pragma unroll
                for (int bj = 0; bj < 2; ++bj) {
                    f32x4 b0, b1; unpack8(*(const u32x4*)(Gt + (size_t)row * 2048 + 1024 + col + bj * HALF), b0, b1);
                    *(u32x4*)(Out + (size_t)row * 1024 + col + bj * HALF) = pack8(acc[ai][bj][m][0] * b0, acc[ai][bj][m][1] * b1);
                }
            }
    }
};
struct EpiX1 {
    static constexpr bool PERM = true, AFTER_DRAIN = false;
    const float* x; bf16_t* X1b; float* SS;
    __device__ __forceinline__ void init(f32x4 (&acc)[2][2][4][2], const Unit& u, int wr, int wc, int fr, int fq) const {
        const int row0 = u.pm * BM + wr * 64 + fr, col = u.pn * BM + wc * 32 + 8 * fq;
#pragma unroll
        for (int ai = 0; ai < 2; ++ai)
#pragma unroll
            for (int m = 0; m < 4; ++m)
#pragma unroll
                for (int bj = 0; bj < 2; ++bj) { const float* p = x + (size_t)(row0 + ai * HALF + m * 16) * 1024 + col + bj * HALF; acc[ai][bj][m][0] = *(const f32x4*)p; acc[ai][bj][m][1] = *(const f32x4*)(p + 4); }
    }
    __device__ __forceinline__ void operator()(const f32x4 (&acc)[2][2][4][2], const Unit& u, int wr, int wc, int fr, int fq) const {
        const int row0 = u.pm * BM + wr * 64 + fr, col = u.pn * BM + wc * 32 + 8 * fq;
#pragma unroll
        for (int ai = 0; ai < 2; ++ai)
#pragma unroll
            for (int m = 0; m < 4; ++m) {
                const int row = row0 + ai * HALF + m * 16; float ss = 0.f;
#pragma unroll
                for (int bj = 0; bj < 2; ++bj) {
                    const size_t off = (size_t)row * 1024 + col + bj * HALF;
                    const f32x4 o0 = acc[ai][bj][m][0], o1 = acc[ai][bj][m][1];
                    *(u32x4*)(X1b + off) = pack8(o0, o1);
                    ss += hsum4(o0 * o0) + hsum4(o1 * o1);
                }
                ss += __shfl_xor(ss, 16); ss += __shfl_xor(ss, 32);
                if (fq == 0) SS[(size_t)row * 16 + u.pn * 4 + wc] = ss;
            }
    }
};
struct EpiUp {
    static constexpr bool PERM = true, AFTER_DRAIN = false;
    const float* SS; bf16_t* U;
    __device__ __forceinline__ void operator()(const f32x4 (&acc)[2][2][4][2], const Unit& u, int wr, int wc, int fr, int fq) const {
        const int row0 = u.pm * BM + wr * 64 + fr, col = u.pn * BM + wc * 32 + 8 * fq;
#pragma unroll
        for (int ai = 0; ai < 2; ++ai)
#pragma unroll
            for (int m = 0; m < 4; ++m) {
                const int row = row0 + ai * HALF + m * 16;
                float ssum = hsum4(*(const f32x4*)(SS + (size_t)row * 16 + 4 * fq));
                ssum += __shfl_xor(ssum, 16); ssum += __shfl_xor(ssum, 32);
                const float rs = __builtin_amdgcn_rsqf(ssum * (1.f / 1024.f) + 1e-6f);
#pragma unroll
                for (int bj = 0; bj < 2; ++bj) {
                    f32x4 a = acc[ai][bj][m][0] * rs, b = acc[ai][bj][m][1] * rs;
#pragma unroll
                    for (int e = 0; e < 4; ++e) { a[e] = fmaxf(a[e], 0.f); b[e] = fmaxf(b[e], 0.f); }
                    st_nt(U + (size_t)row * 4096 + col + bj * HALF, pack8(a * a, b * b));
                }
            }
    }
};
struct EpiDown {
    static constexpr bool PERM = true, AFTER_DRAIN = false;
    const bf16_t* X1b; float* out;
    __device__ __forceinline__ void init(f32x4 (&acc)[2][2][4][2], const Unit& u, int wr, int wc, int fr, int fq) const {
        const int row0 = u.pm * BM + wr * 64 + fr, col = u.pn * BM + wc * 32 + 8 * fq;
#pragma unroll
        for (int ai = 0; ai < 2; ++ai)
#pragma unroll
            for (int m = 0; m < 4; ++m)
#pragma unroll
                for (int bj = 0; bj < 2; ++bj) unpack8(*(const u32x4*)(X1b + (size_t)(row0 + ai * HALF + m * 16) * 1024 + col + bj * HALF), acc[ai][bj][m][0], acc[ai][bj][m][1]);
    }
    __device__ __forceinline__ void operator()(const f32x4 (&acc)[2][2][4][2], const Unit& u, int wr, int wc, int fr, int fq) const {
        const int row0 = u.pm * BM + wr * 64 + fr, col = u.pn * BM + wc * 32 + 8 * fq;
#pragma unroll
        for (int ai = 0; ai < 2; ++ai)
#pragma unroll
            for (int m = 0; m < 4; ++m) {
                const int row = row0 + ai * HALF + m * 16;
#pragma unroll
                for (int bj = 0; bj < 2; ++bj) {
                    const size_t off = (size_t)row * 1024 + col + bj * HALF;
                    st_nt(out + off, acc[ai][bj][m][0]); st_nt(out + off + 4, acc[ai][bj][m][1]);
                }
            }
    }
};

template <class Epi, class Sched, bool ALIGN_EPI = false, bool SP2 = false, int MID_T = 0, bool ACC_INIT = false>
__device__ __forceinline__ void gemm_phase(PG8_LAS unsigned char* lds, const Gemm g, const Sched& S, const Epi& E) {
    const int tid = threadIdx.x, wid = __builtin_amdgcn_readfirstlane(tid >> 6), lane = tid & 63, wr = wid >> 2, wc = wid & 3, fr = lane & 15, fq = lane >> 4;
    const int K = g.K, nt = K / BK;
    unsigned voffA[2], voffB[2];
#pragma unroll
    for (int i = 0; i < 2; ++i) { int R, C; stage_rc(tid * 16 + i * 8192, R, C); const int Rb = Epi::PERM ? ((R & ~31) + perm32(R & 31)) : R;
        voffA[i] = (unsigned)(R * K + C) * 2u; voffB[i] = (unsigned)(Rb * K + C) * 2u; }
    const size_t kstep = (size_t)(BK * 2);
    const size_t hstep = (size_t)HALF * K * 2;
    const size_t tstep = 2 * hstep;
    const unsigned ldsw = (unsigned)wid * 1024u;
    const int aoff = lds_byte(wr * 64 + fr, fq * 8), boff = lds_byte(wc * 32 + fr, fq * 8);
#define PG8_SA(b, h) (((b) * 2 + (h)) * HTB)
#define PG8_SB(b, h) ((4 + (b) * 2 + (h)) * HTB)
#define PG8_STAGE(bufoff, gbase, voff) do { _Pragma("unroll") for (int _i = 0; _i < 2; ++_i) \
        __builtin_amdgcn_global_load_lds((const unsigned*)((const char*)(gbase) + (voff)[_i]), (PG8_LAS unsigned*)(lds + (bufoff) + ldsw + _i * 8192), 16, 0, 0); } while (0)
#define PG8_LDA(dst, b, h) do { _Pragma("unroll") for (int m = 0; m < 4; ++m) _Pragma("unroll") for (int k = 0; k < 2; ++k) dst[m][k] = *(const PG8_LAS bf16x8*)(lds + PG8_SA(b, h) + aoff + m * 2048 + k * 1024); } while (0)
#define PG8_LDB(dst, b, h) do { _Pragma("unroll") for (int n = 0; n < 2; ++n) _Pragma("unroll") for (int k = 0; k < 2; ++k) dst[n][k] = *(const PG8_LAS bf16x8*)(lds + PG8_SB(b, h) + boff + n * 2048 + k * 1024); } while (0)
#define PG8_MMA(ai, bj, At, Bt) do { __builtin_amdgcn_s_setprio(1); _Pragma("unroll") for (int m = 0; m < 4; ++m) _Pragma("unroll") for (int n = 0; n < 2; ++n) _Pragma("unroll") for (int k = 0; k < 2; ++k) \
        acc[ai][bj][m][n] = __builtin_amdgcn_mfma_f32_16x16x32_bf16(Bt[n][k], At[m][k], acc[ai][bj][m][n], 0, 0, 0); __builtin_amdgcn_s_setprio(0); } while (0)
#define PG8_WAIT_V(n) asm volatile("s_waitcnt vmcnt(" #n ")" ::: "memory")
#define PG8_WAIT_L(n) asm volatile("s_waitcnt lgkmcnt(" #n ")" ::: "memory")
#define PG8_BAR __builtin_amdgcn_s_barrier()
#define PG8_SCHED __builtin_amdgcn_sched_barrier(0)
    Unit cur, nxt; int ui = 0;
    if (!S.next(0, cur)) return;
    f32x4 acc[2][2][4][2];
#pragma unroll
    for (int a = 0; a < 2; ++a)
#pragma unroll
        for (int b = 0; b < 2; ++b)
#pragma unroll
            for (int m = 0; m < 4; ++m)
#pragma unroll
                for (int n = 0; n < 2; ++n) { if constexpr (!ACC_INIT) acc[a][b][m][n] = (f32x4){0.f, 0.f, 0.f, 0.f}; }
    if constexpr (ACC_INIT) E.init(acc, cur, wr, wc, fr, fq);
    bf16x8 At[4][2], B0[2][2], B1[2][2];
    const char* cA = (const char*)g.A + (size_t)cur.pm * tstep; const char* cB = (const char*)g.Bt + (size_t)cur.pn * tstep;
    S.a_ready(cur);
    if constexpr (SP2) {
        PG8_STAGE(PG8_SB(0, 0), cB, voffB); PG8_STAGE(PG8_SB(0, 1), cB + hstep, voffB); PG8_STAGE(PG8_SA(0, 0), cA, voffA); PG8_STAGE(PG8_SA(0, 1), cA + hstep, voffA);
        if (wr == 1) PG8_BAR;
        PG8_WAIT_V(2); PG8_BAR;
        PG8_STAGE(PG8_SB(1, 0), cB + kstep, voffB); PG8_STAGE(PG8_SA(1, 0), cA + kstep, voffA); PG8_STAGE(PG8_SB(1, 1), cB + hstep + kstep, voffB);
        PG8_WAIT_V(6); PG8_BAR;
    } else {
        PG8_STAGE(PG8_SB(0, 0), cB, voffB); PG8_STAGE(PG8_SA(0, 0), cA, voffA); PG8_STAGE(PG8_SB(0, 1), cB + hstep, voffB); PG8_STAGE(PG8_SA(0, 1), cA + hstep, voffA);
        if (wr == 1) PG8_BAR;
        PG8_WAIT_V(4); PG8_BAR;
        PG8_STAGE(PG8_SB(1, 0), cB + kstep, voffB); PG8_STAGE(PG8_SA(1, 0), cA + kstep, voffA); PG8_STAGE(PG8_SB(1, 1), cB + hstep + kstep, voffB);
        PG8_WAIT_V(6); PG8_BAR;
    }
    for (;;) {
        const bool has_next = S.next(ui + 1, nxt);
        const char* nA = has_next ? (const char*)g.A + (size_t)nxt.pm * tstep : cA; const char* nB = has_next ? (const char*)g.Bt + (size_t)nxt.pn * tstep : cB;
        for (int t = 0; t < nt; t += 2) {
            const bool last = (t == nt - 2);
            if constexpr (MID_T > 0) { if (t == MID_T) E.mid(acc, cur, wr, wc, fr, fq); }
            const char* a1 = cA + (size_t)(t + 1) * kstep;
            const char* a2 = last ? nA : cA + (size_t)(t + 2) * kstep; const char* b2 = last ? nB : cB + (size_t)(t + 2) * kstep;
            const char* a3 = a2 + kstep; const char* b3 = b2 + kstep;
            if (last && has_next) S.a_ready(nxt);
            if constexpr (SP2) {
            PG8_LDB(B0, 0, 0); PG8_LDB(B1, 0, 1); PG8_SCHED; PG8_LDA(At, 0, 0); PG8_STAGE(PG8_SA(1, 1), a1 + hstep, voffA);
            PG8_WAIT_V(8); PG8_WAIT_L(0); PG8_BAR; PG8_MMA(0, 0, At, B0); PG8_MMA(0, 1, At, B1); PG8_BAR; PG8_SCHED;
            PG8_LDA(At, 0, 1); PG8_STAGE(PG8_SB(0, 0), b2, voffB); PG8_STAGE(PG8_SB(0, 1), b2 + hstep, voffB); PG8_STAGE(PG8_SA(0, 0), a2, voffA);
            PG8_WAIT_V(8); PG8_WAIT_L(0); PG8_BAR; PG8_MMA(1, 0, At, B0); PG8_MMA(1, 1, At, B1); PG8_BAR; PG8_SCHED;
            PG8_LDB(B0, 1, 0); PG8_LDB(B1, 1, 1); PG8_SCHED; PG8_LDA(At, 1, 0); PG8_STAGE(PG8_SA(0, 1), a2 + hstep, voffA);
            PG8_WAIT_V(8); PG8_WAIT_L(0); PG8_BAR; PG8_MMA(0, 0, At, B0); PG8_MMA(0, 1, At, B1); PG8_BAR; PG8_SCHED;
            PG8_LDA(At, 1, 1); PG8_STAGE(PG8_SB(1, 0), b3, voffB); PG8_STAGE(PG8_SB(1, 1), b3 + hstep, voffB); PG8_STAGE(PG8_SA(1, 0), a3, voffA);
            PG8_WAIT_V(8); PG8_WAIT_L(0); PG8_BAR; PG8_MMA(1, 0, At, B0); PG8_MMA(1, 1, At, B1); PG8_BAR; PG8_SCHED;
            } else {
            PG8_LDB(B0, 0, 0); PG8_SCHED; PG8_LDA(At, 0, 0); PG8_STAGE(PG8_SA(1, 1), a1 + hstep, voffA);
            PG8_WAIT_L(8); PG8_BAR; PG8_WAIT_L(0); PG8_MMA(0, 0, At, B0); PG8_BAR; PG8_SCHED;
            PG8_LDB(B1, 0, 1); PG8_STAGE(PG8_SB(0, 0), b2, voffB);
            PG8_BAR; PG8_WAIT_L(0); PG8_MMA(0, 1, At, B1); PG8_BAR;
            PG8_LDA(At, 0, 1); PG8_STAGE(PG8_SA(0, 0), a2, voffA);
            PG8_BAR; PG8_WAIT_L(0); PG8_MMA(1, 0, At, B0); PG8_BAR; PG8_SCHED;
            PG8_STAGE(PG8_SB(0, 1), b2 + hstep, voffB);
            PG8_WAIT_V(6); PG8_BAR; PG8_MMA(1, 1, At, B1); PG8_BAR;
            PG8_LDB(B0, 1, 0); PG8_SCHED; PG8_LDA(At, 1, 0); PG8_STAGE(PG8_SA(0, 1), a2 + hstep, voffA);
            PG8_WAIT_L(8); PG8_BAR; PG8_WAIT_L(0); PG8_MMA(0, 0, At, B0); PG8_BAR; PG8_SCHED;
            PG8_LDB(B1, 1, 1); PG8_STAGE(PG8_SB(1, 0), b3, voffB);
            PG8_BAR; PG8_WAIT_L(0); PG8_MMA(0, 1, At, B1); PG8_BAR;
            PG8_LDA(At, 1, 1); PG8_STAGE(PG8_SA(1, 0), a3, voffA);
            PG8_BAR; PG8_WAIT_L(0); PG8_MMA(1, 0, At, B0); PG8_BAR; PG8_SCHED;
            PG8_STAGE(PG8_SB(1, 1), b3 + hstep, voffB);
            PG8_WAIT_V(6); PG8_BAR; PG8_MMA(1, 1, At, B1); PG8_BAR;
            }
        }
        if constexpr (ALIGN_EPI) { if (wr == 0) PG8_BAR; }
        if constexpr (!Epi::AFTER_DRAIN) { E(acc, cur, wr, wc, fr, fq); S.done(cur); }
        if (!has_next) break;
#pragma unroll
        for (int a = 0; a < 2; ++a)
#pragma unroll
            for (int b = 0; b < 2; ++b)
#pragma unroll
                for (int m = 0; m < 4; ++m)
#pragma unroll
                    for (int n = 0; n < 2; ++n) { if constexpr (!ACC_INIT) acc[a][b][m][n] = (f32x4){0.f, 0.f, 0.f, 0.f}; }
        if constexpr (ACC_INIT) E.init(acc, nxt, wr, wc, fr, fq);
        cur = nxt; cA = nA; cB = nB; ++ui;
        if constexpr (ALIGN_EPI) { if (wr == 1) PG8_BAR; }
    }
    PG8_WAIT_V(0);
    if constexpr (!ALIGN_EPI) { if (wr == 0) PG8_BAR; }
    PG8_BAR;
    if constexpr (Epi::AFTER_DRAIN) { E.fused(acc, cur, wr, wc, fr, fq, lds, wid, lane); S.done(cur); }
#undef PG8_SA
#undef PG8_SB
#undef PG8_STAGE
#undef PG8_LDA
#undef PG8_LDB
#undef PG8_MMA
#undef PG8_WAIT_V
#undef PG8_WAIT_L
#undef PG8_BAR
#undef PG8_SCHED
}
}

constexpr int NWAVES = 8;
constexpr int BATCH = 8, SEQ = 4096, D = 1024, FF = 4096, M = BATCH * SEQ, INW = 5632;
constexpr size_t MiB = 1u << 20;
constexpr size_t WS_CS = 1 * MiB;
constexpr size_t WS_WIN = 2 * MiB, WS_WCAT = 14 * MiB, WS_WOUT = 18 * MiB, WS_WUP = 20 * MiB, WS_WDN = 28 * MiB;
constexpr size_t WS_SS = 36 * MiB;
constexpr size_t WS_QKV = 40 * MiB;
constexpr size_t WS_GLU = 136 * MiB;
constexpr size_t WS_G = 200 * MiB;
constexpr size_t WS_ACAT = 328 * MiB;
constexpr size_t WS_H = 328 * MiB;
constexpr size_t WS_U = 200 * MiB;
constexpr size_t WS_END = 456 * MiB;
constexpr int RING_BYTES = 131072, LDS_BYTES = RING_BYTES + 64 + 2048;

#define GAS __attribute__((address_space(1)))
#define LAS __attribute__((address_space(3)))
typedef unsigned short bf16;
typedef unsigned v4u __attribute__((ext_vector_type(4)));
typedef unsigned v2u __attribute__((ext_vector_type(2)));
typedef float f32x4 __attribute__((ext_vector_type(4)));
typedef float f32x2 __attribute__((ext_vector_type(2)));
typedef float f32x16 __attribute__((ext_vector_type(16)));
typedef short bf16x8 __attribute__((ext_vector_type(8)));
typedef short s16x4 __attribute__((ext_vector_type(4)));
#define LDS_WAIT() asm volatile("s_waitcnt lgkmcnt(0)" ::: "memory")
__device__ __forceinline__ unsigned f2bf(float f) { unsigned u = __builtin_bit_cast(unsigned, f); return (u + 0x7fffu + ((u >> 16) & 1u)) >> 16; }
__device__ __forceinline__ unsigned pk2(float lo, float hi) { return f2bf(lo) | (f2bf(hi) << 16); }
__device__ __forceinline__ float wave_sum(float v) {
#pragma unroll
    for (int o = 1; o < 64; o <<= 1) v += __shfl_xor(v, o);
    return v;
}

__device__ __forceinline__ int win_row_map(int n0) {
    if (n0 < 1536) { const int tile = n0 >> 8, local = n0 & 255, wc = local >> 6, bj = (local >> 5) & 1; return tile * 256 + bj * 128 + wc * 32; }
    if (n0 < 3584) { const int cc = n0 - 1536, half = cc >> 10, ch = cc & 1023; return 1536 + (ch >> 7) * 256 + half * 128 + (ch & 127); }
    return n0;
}
#define W_LD(p) __builtin_nontemporal_load(p)
struct P0Item { const float* W; bf16* WT; const float* kscale; int N, ldk, k0, n0, r0; };
__device__ __forceinline__ void p0_item_load(const P0Item& t, float (&w)[32], int lane) {
#pragma unroll
    for (int i = 0; i < 32; ++i) { const int kk = 2 * i + (lane >> 5); w[i] = W_LD(t.W + (size_t)(t.k0 + kk) * t.N + t.n0 + (lane & 31)); }
}
__device__ __forceinline__ void p0_item_finish(const P0Item& t, const float (&w)[32], LAS float* scr, int lane) {
#pragma unroll
    for (int i = 0; i < 32; ++i) { const int kk = 2 * i + (lane >> 5); float v = w[i]; if (t.kscale) v *= t.kscale[t.k0 + kk]; scr[kk * 33 + (lane & 31)] = v; }
    LDS_WAIT(); asm volatile("" ::: "memory");
    const int c = lane & 7;
#pragma unroll
    for (int j = 0; j < 4; ++j) { const int n = (lane >> 3) + 8 * j; const LAS float* sp = scr + (8 * c) * 33 + n;
        v4u o; o.x = pk2(sp[0 * 33], sp[1 * 33]); o.y = pk2(sp[2 * 33], sp[3 * 33]); o.z = pk2(sp[4 * 33], sp[5 * 33]); o.w = pk2(sp[6 * 33], sp[7 * 33]);
        *(GAS v4u*)(t.WT + (size_t)(t.r0 + n) * t.ldk + t.k0 + 8 * c) = o; }
    LDS_WAIT(); asm volatile("" ::: "memory");
}
__device__ __forceinline__ void rms_rows_to_bf16(const float* xrow, const float* g, bf16* orow, int lane, size_t rstride) {
    constexpr int NR = 4;
    const f32x4* gr = (const f32x4*)g + lane;
    f32x4 v[NR][4]; float s[NR];
#pragma unroll
    for (int r = 0; r < NR; ++r) { const GAS f32x4* xr = (const GAS f32x4*)(xrow + r * rstride) + lane; s[r] = 0.f;
#pragma unroll
        for (int j = 0; j < 4; ++j) { v[r][j] = __builtin_nontemporal_load(xr + 64 * j); } }
#pragma unroll
    for (int r = 0; r < NR; ++r) {
#pragma unroll
        for (int j = 0; j < 4; ++j) s[r] += (v[r][j].x * v[r][j].x + v[r][j].y * v[r][j].y) + (v[r][j].z * v[r][j].z + v[r][j].w * v[r][j].w);
        const float rs = 1.f / sqrtf(wave_sum(s[r]) * (1.f / D) + 1e-6f);
        GAS unsigned long long* o8 = (GAS unsigned long long*)(orow + r * rstride) + lane;
#pragma unroll
        for (int j = 0; j < 4; ++j) { const f32x4 w = v[r][j] * rs * gr[64 * j]; o8[64 * j] = (unsigned long long)pk2(w.x, w.y) | ((unsigned long long)pk2(w.z, w.w) << 32); }
    }
}

namespace att {
constexpr int KP = 144, KROWS = 192, LDS_K = 0, LDS_V = KROWS * KP;
__device__ __forceinline__ int crow(int r, int hi) { return (r & 3) + 8 * (r >> 2) + 4 * hi; }
typedef float f32x2_t __attribute__((ext_vector_type(2))); typedef __bf16 bf16x2_t __attribute__((ext_vector_type(2)));
__device__ __forceinline__ unsigned cvtpk(float lo, float hi) { f32x2_t v = {lo, hi}; bf16x2_t b = __builtin_convertvector(v, bf16x2_t); return __builtin_bit_cast(unsigned, b); }
typedef short v4i16_t __attribute__((ext_vector_type(4)));
__device__ __forceinline__ s16x4 vtr(const LAS unsigned char* p) { return __builtin_bit_cast(s16x4, __builtin_amdgcn_ds_read_tr16_b64_v4i16((LAS v4i16_t*)p)); }
struct Stage { v4u r[6]; };
__device__ __forceinline__ void stage_load(Stage& st, const bf16* QKV, long tok0, int r0, int kvh, int tid) {
#pragma unroll
    for (int j = 0; j < 6; ++j) { const int cc = tid + 512 * (j % 3), row = cc >> 3, ch = cc & 7; int kpos = r0 - 128 + row; kpos = kpos < 0 ? 0 : kpos;
        st.r[j] = *(const GAS v4u*)(QKV + (size_t)(tok0 + kpos) * 1536 + 1024 + (j / 3) * 256 + kvh * 64 + ch * 8); }
}
__device__ __forceinline__ void stage_store(const Stage& st, LAS unsigned char* lds, int tid) {
#pragma unroll
    for (int j = 0; j < 6; ++j) { const int cc = tid + 512 * (j % 3), row = cc >> 3, ch = cc & 7; *(LAS v4u*)(lds + (j / 3) * LDS_V + row * KP + ch * 16) = st.r[j]; }
}
__device__ __forceinline__ void unit_compute(const LAS unsigned char* lds, const bf16* QKV, bf16* O, const float* sinks, long tok0, int r0, int kvh, int wid, int lane) {
    const int r = lane & 31, h = lane >> 5;
    const int head = kvh * 4 + (wid >> 1), sub = wid & 1, w0 = r0 + 32 * sub, koff = 32 * sub;
    const bf16* qp = QKV + (size_t)(tok0 + w0 + r) * 1536 + head * 64 + 8 * h;
    bf16x8 qr[4];
#pragma unroll
    for (int ds = 0; ds < 4; ++ds) qr[ds] = *(const GAS bf16x8*)(qp + 16 * ds);
    f32x16 S[5];
#pragma unroll
    for (int kb = 0; kb < 5; ++kb) {
        f32x16 a = {};
#pragma unroll
        for (int ds = 0; ds < 4; ++ds) { const bf16x8 kf = *(const LAS bf16x8*)(lds + LDS_K + (koff + 32 * kb + r) * KP + (16 * ds + 8 * h) * 2); a = __builtin_amdgcn_mfma_f32_32x32x16_bf16(kf, qr[ds], a, 0, 0, 0); }
        S[kb] = a; __builtin_amdgcn_sched_barrier(0);
    }
    const float NEG = -INFINITY;
    const int rh = r - 4 * h;
#pragma unroll
    for (int i = 0; i < 16; ++i) { const int ci = (i & 3) + 8 * (i >> 2); if (ci <= rh) S[0][i] = NEG; if (ci > rh) S[4][i] = NEG; }
    if (w0 < 128) { const int limh = 128 - w0 - 4 * h;
#pragma unroll
        for (int kb = 0; kb < 4; ++kb)
#pragma unroll
            for (int i = 0; i < 16; ++i) if (32 * kb + (i & 3) + 8 * (i >> 2) < limh) S[kb][i] = NEG; }
    const float sk = sinks[head] * 1.4426950408889634f;
    float mx = sk;
#pragma unroll
    for (int kb = 0; kb < 5; ++kb)
#pragma unroll
        for (int i = 0; i < 16; ++i) mx = fmaxf(mx, S[kb][i]);
    mx = fmaxf(mx, __shfl_xor(mx, 32));
    float l = 0.f;
#pragma unroll
    for (int kb = 0; kb < 5; ++kb)
#pragma unroll
        for (int i = 0; i < 16; ++i) { const float p = __builtin_amdgcn_exp2f(S[kb][i] - mx); S[kb][i] = p; l += p; }
    l += __shfl_xor(l, 32); l += __builtin_amdgcn_exp2f(sk - mx);
    const float inv = 1.f / l;
    f32x16 o0 = {}, o1 = {};
    const int i16 = lane & 15, q_ = i16 >> 2, p_ = i16 & 3, blk = (lane >> 4) & 1;
    const LAS unsigned char* vb = lds + LDS_V + (koff + 4 * h + q_) * KP + 32 * blk + 8 * p_;
#pragma unroll
    for (int kb = 0; kb < 5; ++kb)
#pragma unroll
        for (int s = 0; s < 2; ++s) {
            v4u pw;
#pragma unroll
            for (int e = 0; e < 4; ++e) pw[e] = cvtpk(S[kb][8 * s + 2 * e] * inv, S[kb][8 * s + 2 * e + 1] * inv);
            const bf16x8 pa = __builtin_bit_cast(bf16x8, pw);
            const LAS unsigned char* vp = vb + (32 * kb + 16 * s) * KP;
            const s16x4 lo0 = vtr(vp), hi0 = vtr(vp + 8 * KP), lo1 = vtr(vp + 64), hi1 = vtr(vp + 8 * KP + 64);
            const bf16x8 v0 = __builtin_shufflevector(lo0, hi0, 0, 1, 2, 3, 4, 5, 6, 7), v1 = __builtin_shufflevector(lo1, hi1, 0, 1, 2, 3, 4, 5, 6, 7);
            o0 = __builtin_amdgcn_mfma_f32_32x32x16_bf16(pa, v0, o0, 0, 0, 0);
            o1 = __builtin_amdgcn_mfma_f32_32x32x16_bf16(pa, v1, o1, 0, 0, 0);
            __builtin_amdgcn_sched_barrier(0);
        }
    bf16* op = O + (size_t)(tok0 + w0) * 2048 + head * 64 + r;
#pragma unroll
    for (int i = 0; i < 16; ++i) { const int rw = crow(i, h); const unsigned pk = pg8::cvt_pk_bf16(o0[i], o1[i]); op[(size_t)rw * 2048] = (bf16)(pk & 0xffffu); op[(size_t)rw * 2048 + 32] = (bf16)(pk >> 16); }
}
}

constexpr int CONV_PART_OFF = 131072 + 64;
__device__ __forceinline__ void conv_dma_rows(LAS unsigned char* lds, const bf16* GLU, int c0, int kb, int ke, int wid, int lane) {
    for (int p = 2 * kb + wid; p < 2 * ke; p += 8) {
        const int k = p >> 1, half = p & 1, grow = c0 - 30 + k;
        if (grow >= 0) __builtin_amdgcn_global_load_lds((const unsigned*)(GLU + (size_t)grow * 1024 + half * 512 + lane * 8), (LAS unsigned*)(lds + (k & 63) * 2048 + half * 1024), 16, 0, 0);
    }
}
template <int I> __device__ __forceinline__ void conv_steps(f32x2 (&acc)[32], const f32x2 (&w)[31], const LAS unsigned char* b0, const LAS unsigned char* b1, bool zero_head) {
    unsigned u = *(const LAS unsigned*)((I < 32 ? b0 : b1) + (I & 31) * 2048);
    if (I < 30) u = zero_head ? 0u : u;
    const f32x2 xv = {__uint_as_float(u << 16), __uint_as_float(u & 0xffff0000u)};
#pragma unroll
    for (int o = 0; o < 32; ++o) { if (I - o >= 0 && I - o <= 30) { const f32x2 wj = w[(I - o >= 0 && I - o <= 30) ? I - o : 0];
        asm("v_fmac_f32 %0, %1, %2" : "+v"(acc[o].x) : "v"(wj.x), "v"(xv.x)); asm("v_fmac_f32 %0, %1, %2" : "+v"(acc[o].y) : "v"(wj.y), "v"(xv.y)); } }
    if ((I & 15) == 15) __builtin_amdgcn_sched_barrier(0);
    if constexpr (I + 1 < 62) conv_steps<I + 1>(acc, w, b0, b1, zero_head);
}
#define CONV_BFLY(n) do { const bool up_ = (lane & (n)) != 0; _Pragma("unroll") for (int i_ = 0; i_ < (n); ++i_) { const float a_ = v[i_], b_ = v[i_ + (n)]; \
        const float send_ = up_ ? a_ : b_, keep_ = up_ ? b_ : a_; v[i_] = keep_ + __shfl_xor(send_, (n)); } } while (0)
__device__ __forceinline__ void conv_chunk(LAS unsigned char* lds, const bf16* GLU, bf16* C, const float* cw, const float* cb, const float* ng, const float* nb, int c0, int nunits, int tid, int wid, int lane) {
    f32x2 w[31];
#pragma unroll
    for (int j = 0; j < 31; ++j) w[j] = *(const f32x2*)(cw + j * 1024 + 2 * tid);
    const f32x2 bias = *(const f32x2*)(cb + 2 * tid), g2 = *(const f32x2*)(ng + 2 * tid), b2 = *(const f32x2*)(nb + 2 * tid);
    const LAS unsigned char* bA = lds + tid * 4; const LAS unsigned char* bB = bA + 65536;
    LAS float* part = (LAS float*)(lds + CONV_PART_OFF);
    conv_dma_rows(lds, GLU, c0, 0, 62, wid, lane);
    for (int j = 0; j < nunits; ++j) {
        const int t0 = c0 + 32 * j;
        asm volatile("s_waitcnt vmcnt(0)" ::: "memory"); __syncthreads();
        f32x2 acc[32];
#pragma unroll
        for (int o = 0; o < 32; ++o) acc[o] = bias;
        const bool par = (j & 1) != 0;
        conv_steps<0>(acc, w, par ? bB : bA, par ? bA : bB, (t0 & (SEQ - 1)) == 0);
        __syncthreads();
        if (j + 1 < nunits) conv_dma_rows(lds, GLU, c0, 62 + 32 * j, 94 + 32 * j, wid, lane);
        float v[64];
#pragma unroll
        for (int o = 0; o < 32; ++o) { v[o] = acc[o].x + acc[o].y; v[32 + o] = acc[o].x * acc[o].x + acc[o].y * acc[o].y; }
        CONV_BFLY(32); CONV_BFLY(16); CONV_BFLY(8); CONV_BFLY(4); CONV_BFLY(2); CONV_BFLY(1);
        part[wid * 64 + lane] = v[0];
        __syncthreads();
        float tot = 0.f;
#pragma unroll
        for (int ww = 0; ww < 8; ++ww) tot += part[ww * 64 + lane];
        const float sq = __shfl_xor(tot, 32);
        const float mean = tot * (1.f / 1024.f), var = fmaxf(sq * (1.f / 1024.f) - mean * mean, 0.f), rstd = __builtin_amdgcn_rsqf(var + 1e-6f);
        GAS unsigned* cp = (GAS unsigned*)(C + (size_t)t0 * 2048) + tid;
#pragma unroll
        for (int o = 0; o < 32; ++o) {
            const float m = __builtin_bit_cast(float, __builtin_amdgcn_readlane(__builtin_bit_cast(int, mean), o)), r = __builtin_bit_cast(float, __builtin_amdgcn_readlane(__builtin_bit_cast(int, rstd), o));
            f32x2 z = (acc[o] - m) * r * g2 + b2; z.x = z.x * pg8::sigm(z.x); z.y = z.y * pg8::sigm(z.y);
            __builtin_nontemporal_store(pg8::cvt_pk_bf16(z.x, z.y), cp + (size_t)o * 1024);
        }
    }
    __syncthreads();
}

#define XB_TMO      128
#define XB_XCNT(j)  (256  + 64 * (j))
#define XB_XSUB(j)  (1280 + 64 * (j))
#define XB_XGEN(j)  (2304 + 64 * (j))
#define XB_TOP      3328
#define XB_TOPGEN   3392
#define XCD_BAR_WORDS 3456
#define XB_SPIN_CAP (1u << 18)

__device__ __forceinline__ unsigned xb_ld(unsigned* p)              { return __hip_atomic_load(p, __ATOMIC_RELAXED, __HIP_MEMORY_SCOPE_AGENT); }
__device__ __forceinline__ unsigned xb_add(unsigned* p, unsigned v) { return __hip_atomic_fetch_add(p, v, __ATOMIC_RELAXED, __HIP_MEMORY_SCOPE_AGENT); }
__device__ __forceinline__ unsigned xb_xcc_id() { return (unsigned)__builtin_amdgcn_s_getreg((3 << 11) | 20) & 0xFu; }
#define XB_SPIN(cond, bar) do { unsigned _sp = 0; while (cond) { __builtin_amdgcn_s_sleep(1); \
    if ((++_sp & 255u) == 0u) { if (xb_ld(&(bar)[XB_TMO])) break; if (_sp > XB_SPIN_CAP) { atomicAdd(&(bar)[XB_TMO], 1u); break; } } } } while (0)

struct XcdBarrier {
    unsigned* bar; unsigned x;
    volatile LAS unsigned* st;
};

__device__ __forceinline__ XcdBarrier xcd_barrier_post(unsigned* bar, volatile LAS unsigned* st) {
    XcdBarrier b; b.bar = bar; b.x = xb_xcc_id(); b.st = st;
    if (threadIdx.x == 0) (void)xb_add(&bar[XB_XCNT(b.x)], 1u);
    return b;
}
__device__ __forceinline__ void xcd_barrier_complete(unsigned* bar, unsigned x, unsigned& nloc, unsigned& nx) {
    const unsigned G = gridDim.x * gridDim.y * gridDim.z;
    unsigned sum, cnt, mine, sp = 0u;
    for (;;) {
        sum = 0u; cnt = 0u; mine = 0u;
#pragma unroll
        for (unsigned j = 0; j < 16; ++j) { const unsigned c = xb_ld(&bar[XB_XCNT(j)]); sum += c; cnt += (c > 0u) ? 1u : 0u; mine = (j == x) ? c : mine; }
        if (sum == G) break;
        __builtin_amdgcn_s_sleep(1);
        if ((++sp & 255u) == 0u) { if (xb_ld(&bar[XB_TMO])) break; if (sp > XB_SPIN_CAP) { atomicAdd(&bar[XB_TMO], 1u); break; } }
    }
    nloc = mine > 0u ? mine : 1u; nx = cnt > 0u ? cnt : 1u;
}

__device__ __forceinline__ void xcd_barrier(const XcdBarrier& b) {
    asm volatile("s_waitcnt vmcnt(0)" ::: "memory");
    __syncthreads();
    if (threadIdx.x == 0) {
        unsigned* bar = b.bar;
        __builtin_amdgcn_s_waitcnt(0);
        unsigned nloc = b.st[0], nx = b.st[1];
        if (nloc == 0u) { xcd_barrier_complete(bar, b.x, nloc, nx); b.st[0] = nloc; b.st[1] = nx; }
        const unsigned old = xb_add(&bar[XB_XSUB(b.x)], 1u);
        const unsigned gen = old / nloc;
        if (old + 1u == (gen + 1u) * nloc) {
            __builtin_amdgcn_fence(__ATOMIC_RELEASE, "agent");
            asm volatile("s_waitcnt vmcnt(0)" ::: "memory");
            const unsigned og = xb_add(&bar[XB_TOP], 1u);
            const unsigned tg = og / nx;
            if (og + 1u == (tg + 1u) * nx) xb_add(&bar[XB_TOPGEN], 1u);
            else XB_SPIN(xb_ld(&bar[XB_TOPGEN]) == tg, bar);
            __builtin_amdgcn_fence(__ATOMIC_ACQUIRE, "agent");
            xb_add(&bar[XB_XGEN(b.x)], 1u);
            asm volatile("s_waitcnt vmcnt(0)" ::: "memory");
        } else {
            XB_SPIN(xb_ld(&bar[XB_XGEN(b.x)]) == gen, bar);
            __builtin_amdgcn_fence(__ATOMIC_ACQUIRE, "agent");
            asm volatile("s_waitcnt vmcnt(0)" ::: "memory");
        }
    }
    __syncthreads();
}

#ifndef ATT_REP
#define ATT_REP 1
#endif
#ifndef CONV_REP
#define CONV_REP 1
#endif
#ifndef WGM_P1
#define WGM_P1 4
#endif
#ifndef WGM_P5
#define WGM_P5 4
#endif
#ifndef MK_N_LAUNCHES
#define MK_N_LAUNCHES 1
#endif
constexpr int N_PHASES = 7;
struct Args { const float* in[17]; float* out; unsigned char* ws; int ph_lo, ph_hi; };
static_assert(sizeof(Args) == 17 * 8 + 8 + 8 + 8, "Args has no padding");

__global__ void __launch_bounds__(NWAVES * 64, 2) mega_fwd(Args args) {
    extern __shared__ __attribute__((aligned(16))) unsigned char lds_raw[];
    LAS unsigned char* lds = (LAS unsigned char*)lds_raw;
    const int tid = threadIdx.x, lane = tid & 63, wid = __builtin_amdgcn_readfirstlane(tid >> 6);
    const int G = gridDim.x, bx = blockIdx.x;
    const int vcu = (G % 8 == 0) ? (bx % 8) * (G / 8) + bx / 8 : bx;
    volatile LAS unsigned* xst = (volatile LAS unsigned*)(lds + RING_BYTES);
    if (tid < 16) xst[tid] = 0u;
    __syncthreads();
    XcdBarrier xbar; xbar.bar = (unsigned*)args.ws; xbar.x = 0; xbar.st = xst;
    if (args.ph_hi - args.ph_lo > 1) xbar = xcd_barrier_post((unsigned*)args.ws, xst);
#define ws (args.ws)
#define x (args.in[0])
#define norm1_g (args.in[1])
#define w_in (args.in[2])
#define gate_b (args.in[3])
#define q_norm_g (args.in[4])
#define k_norm_g (args.in[5])
#define sinks (args.in[6])
#define w_attn_out (args.in[7])
#define conv_w (args.in[8])
#define conv_b (args.in[9])
#define conv_norm_g (args.in[10])
#define conv_norm_b (args.in[11])
#define w_conv_out (args.in[12])
#define w_out (args.in[13])
#define norm2_g (args.in[14])
#define w_up (args.in[15])
#define w_down (args.in[16])
#define out (args.out)
#define CS ((float*)(ws + WS_CS))
#define SS ((float*)(ws + WS_SS))
#define Win_t ((bf16*)(ws + WS_WIN))
#define Wcat_t ((bf16*)(ws + WS_WCAT))
#define Wout_t ((bf16*)(ws + WS_WOUT))
#define Wup_t ((bf16*)(ws + WS_WUP))
#define Wdn_t ((bf16*)(ws + WS_WDN))
#define Hb ((bf16*)(ws + WS_H))
#define X1b ((bf16*)(ws + WS_GLU))
#define QKV ((bf16*)(ws + WS_QKV))
#define GLU ((bf16*)(ws + WS_GLU))
#define MRG ((bf16*)(ws + WS_QKV))
#define Gb ((bf16*)(ws + WS_G))
#define ACAT ((bf16*)(ws + WS_ACAT))
#define Ub ((bf16*)(ws + WS_U))
    const int lo = args.ph_lo, hi = args.ph_hi;
#ifndef PH_MASK
#define PH_MASK 0x7f
#endif
#define IN(k) (((PH_MASK >> (k)) & 1) && lo <= (k) && (k) < hi)
#ifndef REP_MASK
#define REP_MASK 0
#endif
#define REPS(k) (((REP_MASK >> (k)) & 1) ? 2 : 1)
#define SEAM(k) do { if (IN(k) && IN((k) + 1)) xcd_barrier(xbar); } while (0)

    if (IN(0)) for (int rep_ = 0; rep_ < REPS(0); ++rep_) {
        LAS float* scr = (LAS float*)(lds + wid * 16384);
        const int gw = vcu * NWAVES + wid, NGW = G * NWAVES;
        constexpr int I_IN = (D / 64) * (INW / 32), I_SQ = (D / 64) * (D / 32), I_UP = (D / 64) * (FF / 32), I_DN = (FF / 64) * (D / 32);
        constexpr int NITEMS = I_IN + 3 * I_SQ + I_UP + I_DN;
        auto decode = [&](int it) -> P0Item {
            P0Item t; int r = it; const float* W; bf16* WT; const float* ks = nullptr; int K, N, ldk; bool map_in = false;
            if (r < I_IN) { W = w_in; WT = Win_t; K = D; N = INW; ldk = D; map_in = true; }
            else if ((r -= I_IN) < I_SQ) { W = w_attn_out; WT = Wcat_t; K = D; N = D; ldk = 2 * D; }
            else if ((r -= I_SQ) < I_SQ) { W = w_conv_out; WT = Wcat_t + D; K = D; N = D; ldk = 2 * D; }
            else if ((r -= I_SQ) < I_SQ) { W = w_out; WT = Wout_t; K = D; N = D; ldk = D; }
            else if ((r -= I_SQ) < I_UP) { W = w_up; WT = Wup_t; K = D; N = FF; ldk = D; ks = norm2_g; }
            else { r -= I_UP; W = w_down; WT = Wdn_t; K = FF; N = D; ldk = FF; }
            (void)K; const int nblk = N / 32, kb = r / nblk, nb = r % nblk;
            t.W = W; t.WT = WT; t.kscale = ks; t.N = N; t.ldk = ldk; t.k0 = 64 * kb; t.n0 = 32 * nb; t.r0 = map_in ? win_row_map(t.n0) : t.n0;
            return t;
        };
        if (gw < NITEMS) {
            float w0[32], w1[32], w2[32]; P0Item t0 = decode(gw), t1 = t0, t2 = t0;
            p0_item_load(t0, w0, lane);
            if (gw + NGW < NITEMS) { t1 = decode(gw + NGW); p0_item_load(t1, w1, lane); }
            for (int it = gw; it < NITEMS; it += NGW) {
                if (it + 2 * NGW < NITEMS) { t2 = decode(it + 2 * NGW); p0_item_load(t2, w2, lane); }
                p0_item_finish(t0, w0, scr, lane);
                t0 = t1; t1 = t2;
#pragma unroll
                for (int i = 0; i < 32; ++i) { w0[i] = w1[i]; w1[i] = w2[i]; }
            }
        }
        for (int m = gw; m < M / 4; m += NGW) rms_rows_to_bf16(x + (size_t)m * D, norm1_g, Hb + (size_t)m * D, lane, (size_t)(M / 4) * D);
        for (int id = bx * (NWAVES * 64) + tid; id < SEQ * 8; id += G * NWAVES * 64) {
            const int pos = id >> 3, i = id & 7;
            const float invf = (i == 0) ? 1.0f : (i == 1) ? 0.193922758102417f : (i == 2) ? 0.03760603070259094f : (i == 3) ? 0.00729266507551074f : (i == 4) ? 0.001414213445968926f
                             : (i == 5) ? 0.00027424818836152554f : (i == 6) ? 5.318296462064609e-05f : 1.0313385246263351e-05f;
            const float ang = (float)pos * invf;
            double rev = (double)ang * 0.15915494309189533577; rev -= __builtin_rint(rev);
            CS[pos * 16 + i] = __builtin_amdgcn_cosf((float)rev); CS[pos * 16 + 8 + i] = __builtin_amdgcn_sinf((float)rev);
        }
    }
    SEAM(0);
    if (IN(1)) for (int rep_ = 0; rep_ < REPS(1); ++rep_) {
        pg8::Gemm g{Hb, Win_t, M, INW, D}; pg8::StaticOrder S; S.init(M, INW, G, bx, WGM_P1);
        pg8::EpiInProj E{QKV, GLU, Gb, gate_b, q_norm_g, k_norm_g, CS};
        pg8::gemm_phase<pg8::EpiInProj, pg8::StaticOrder, true, true>(lds, g, S, E);
    }
    SEAM(1);
    if (IN(2)) for (int rep_ = 0; rep_ < REPS(2); ++rep_) {
#ifndef NO_ATT
        {
            constexpr int NU = BATCH * 4 * (SEQ / 64);
            const int per = (NU + G - 1) / G, u0 = vcu * per, u1 = (u0 + per < NU) ? u0 + per : NU;
            att::Stage st;
            const int nu = u1 - u0, ntot = nu * ATT_REP;
            if (nu > 0) att::stage_load(st, QKV, (long)(u0 >> 8) * SEQ, (u0 & 63) * 64, (u0 >> 6) & 3, tid);
            for (int i = 0; i < ntot; ++i) {
                const int u = u0 + (ATT_REP > 1 ? i % nu : i);
                __syncthreads();
                att::stage_store(st, lds, tid);
                __syncthreads();
                if (i + 1 < ntot) { const int un = u0 + (ATT_REP > 1 ? (i + 1) % nu : i + 1); att::stage_load(st, QKV, (long)(un >> 8) * SEQ, (un & 63) * 64, (un >> 6) & 3, tid); }
                att::unit_compute(lds, QKV, ACAT, sinks, (long)(u >> 8) * SEQ, (u & 63) * 64, (u >> 6) & 3, wid, lane);
            }
        }
#endif
#ifndef NO_CONV
        {
            constexpr int NU = M / 32;
            const int per = (NU + G - 1) / G, u0 = vcu * per, u1 = (u0 + per < NU) ? u0 + per : NU;
            asm volatile("s_waitcnt vmcnt(0) lgkmcnt(0)" ::: "memory"); __syncthreads();
            if (u0 < u1) conv_chunk(lds, GLU, ACAT + 1024, conv_w, conv_b, conv_norm_g, conv_norm_b, u0 * 32, u1 - u0, tid, wid, lane);
        }
#endif
        __syncthreads();
    }
    SEAM(2);
    if (IN(3)) for (int rep_ = 0; rep_ < REPS(3); ++rep_) {
        pg8::Gemm g{ACAT, Wcat_t, M, D, 2 * D}; pg8::StaticOrder S; S.init(M, D, G, bx);
        pg8::EpiMerge E{Gb, MRG};
        pg8::gemm_phase<pg8::EpiMerge, pg8::StaticOrder, true, true, 16>(lds, g, S, E);
    }
    SEAM(3);
    if (IN(4)) for (int rep_ = 0; rep_ < REPS(4); ++rep_) {
        pg8::Gemm g{MRG, Wout_t, M, D, D}; pg8::StaticOrder S; S.init(M, D, G, bx);
        pg8::EpiX1 E{x, X1b, SS};
        pg8::gemm_phase<pg8::EpiX1, pg8::StaticOrder, true, true, 0, true>(lds, g, S, E);
    }
    SEAM(4);
    if (IN(5)) for (int rep_ = 0; rep_ < REPS(5); ++rep_) {
        pg8::Gemm g{X1b, Wup_t, M, FF, D}; pg8::StaticOrder S; S.init(M, FF, G, bx, WGM_P5);
        pg8::EpiUp E{SS, Ub};
        pg8::gemm_phase<pg8::EpiUp, pg8::StaticOrder, true, true>(lds, g, S, E);
    }
    SEAM(5);
    if (IN(6)) for (int rep_ = 0; rep_ < REPS(6); ++rep_) {
        pg8::Gemm g{Ub, Wdn_t, M, D, FF}; pg8::StaticOrder S; S.init(M, D, G, bx);
        pg8::EpiDown E{X1b, out};
        pg8::gemm_phase<pg8::EpiDown, pg8::StaticOrder, true, true, 0, true>(lds, g, S, E);
    }
#ifdef DBG_LAST
    if (lo == DBG_LAST) {
        const bf16* src = (const bf16*)(ws + DBG_OFF);
        for (size_t i = (size_t)bx * 512 + tid; i < (size_t)M * 1024; i += (size_t)G * 512) { const size_t m = i >> 10, c = i & 1023; out[i] = (m < (size_t)DBG_ROWS) ? __uint_as_float((unsigned)src[m * DBG_PITCH + DBG_COL + c] << 16) : 0.f; }
    }
#endif
#undef IN
#undef SEAM
#undef ws
#undef x
#undef norm1_g
#undef w_in
#undef gate_b
#undef q_norm_g
#undef k_norm_g
#undef sinks
#undef w_attn_out
#undef conv_w
#undef conv_b
#undef conv_norm_g
#undef conv_norm_b
#undef w_conv_out
#undef w_out
#undef norm2_g
#undef w_up
#undef w_down
#undef out
}

extern "C" void kernel_launch(void* const* d_in, const int* in_sizes, int n_in, void* d_out, int out_size, void* d_ws, size_t ws_size, hipStream_t stream) {
    static int grid = 0;
    if (grid == 0) {
        if (n_in != 17 || in_sizes[0] != M * D || out_size != M * D || ws_size < WS_END) { fprintf(stderr, "kernel_launch: unexpected shapes (n_in %d, in0 %d, out %d, ws %zu); nothing launched\n", n_in, n_in > 0 ? in_sizes[0] : -1, out_size, ws_size); grid = -1; return; }
        int dev = 0, cus = 0, per_cu = 0;
        if (hipGetDevice(&dev) != hipSuccess || hipDeviceGetAttribute(&cus, hipDeviceAttributeMultiprocessorCount, dev) != hipSuccess) { grid = -1; return; }
        if (hipFuncSetAttribute((const void*)mega_fwd, hipFuncAttributeMaxDynamicSharedMemorySize, LDS_BYTES) != hipSuccess) { fprintf(stderr, "kernel_launch: hipFuncSetAttribute failed\n"); grid = -1; return; }
        if (hipOccupancyMaxActiveBlocksPerMultiprocessor(&per_cu, (const void*)mega_fwd, NWAVES * 64, LDS_BYTES) != hipSuccess || per_cu < 1) { fprintf(stderr, "kernel_launch: occupancy query says %d blocks per CU\n", per_cu); per_cu = 1; }
        (void)hipGetLastError();
        grid = cus * (per_cu > 1 ? 1 : per_cu);
    }
    if (grid < 0) return;
    if (hipMemsetAsync(d_ws, 0, 16384, stream) != hipSuccess) { fprintf(stderr, "kernel_launch: hipMemsetAsync failed\n"); return; }
    Args a{};
    for (int i = 0; i < 17; ++i) a.in[i] = (const float*)d_in[i];
    a.out = (float*)d_out; a.ws = (unsigned char*)d_ws;
#if MK_N_LAUNCHES == 1
    a.ph_lo = 0; a.ph_hi = N_PHASES;
    void* kargs[] = {&a};
    hipError_t e = hipLaunchCooperativeKernel((const void*)mega_fwd, dim3(grid), dim3(NWAVES * 64), kargs, LDS_BYTES, stream);
    if (e != hipSuccess) fprintf(stderr, "kernel_launch: cooperative launch failed: %s (grid %d)\n", hipGetErrorString(e), grid);
#else
#ifdef DBG_LAST
    for (int p = 0; p <= DBG_LAST; ++p) { a.ph_lo = p; a.ph_hi = p + 1; hipLaunchKernelGGL(mega_fwd, dim3(grid), dim3(NWAVES * 64), LDS_BYTES, stream, a); }
#else
#ifndef DUP_PHASE
#define DUP_PHASE -1
#endif
    for (int p = 0; p < N_PHASES; ++p) { a.ph_lo = p; a.ph_hi = p + 1; hipLaunchKernelGGL(mega_fwd, dim3(grid), dim3(NWAVES * 64), LDS_BYTES, stream, a);
        if (p == DUP_PHASE) hipLaunchKernelGGL(mega_fwd, dim3(grid), dim3(NWAVES * 64), LDS_BYTES, stream, a); }
#endif
#endif
}
```

```cpp
#include <hip/hip_runtime.h>
#include <hip/hip_cooperative_groups.h>
#include <cstdio>
#include <cstdint>
namespace cg = cooperative_groups;
namespace pg8 {
#define PG8_LAS __attribute__((address_space(3)))
typedef unsigned short bf16_t;
typedef short bf16x8 __attribute__((ext_vector_type(8)));
typedef float f32x4 __attribute__((ext_vector_type(4)));
typedef unsigned u32x4 __attribute__((ext_vector_type(4)));
constexpr int BM = 256, BK = 64, HALF = 128, HTB = HALF * BK * 2  , STAGE_BYTES = 8 * HTB, NXCD = 8, WGM = 4;

__host__ __device__ __forceinline__ int lds_byte(int r, int c) { const int st = (r >> 4) * 2 + (c >> 5), rr = r & 15, cc = c & 31, ob = rr * 64 + cc * 2; return st * 1024 + (ob ^ (((ob >> 9) & 1) << 5)); }
__host__ __device__ __forceinline__ void stage_rc(int b, int& R, int& C) { const int st = b / 1024, sb = b % 1024, swz = sb ^ (((sb >> 9) & 1) << 5); R = (st >> 1) * 16 + swz / 64; C = (st & 1) * 32 + (swz % 64) / 2; }
__host__ __device__ __forceinline__ int perm32(int rho) { const int n = rho >> 4, i = rho & 15; return 8 * (i >> 2) + 4 * n + (i & 3); }

struct Unit { int pm, pn; };
struct Gemm { const bf16_t* A; const bf16_t* Bt; int M, N, K; };

struct StaticOrder {
    int nM, nN, nwg, G, c, wgm;
    __host__ __device__ void init(int M, int N, int G_, int c_, int wgm_ = WGM) { nM = M / BM; nN = N / BM; nwg = nM * nN; G = G_; c = c_; wgm = wgm_; }
    __host__ __device__ bool next(int i, Unit& u) const {
        const long L = (long)i * G + c; if (L >= nwg) return false;
        int wgid = (int)L; { const int q = nwg / NXCD, r = nwg % NXCD, xcd = wgid % NXCD, off = wgid / NXCD; wgid = (xcd < r ? xcd * (q + 1) : r * (q + 1) + (xcd - r) * q) + off; }
        const int nig = wgm * nN, gid = wgid / nig, fm = gid * wgm, gsz = (nM - fm) < wgm ? (nM - fm) : wgm;
        u.pm = fm + ((wgid % nig) % gsz); u.pn = (wgid % nig) / gsz; return true;
    }
    __device__ __forceinline__ void a_ready(const Unit&) const {}
    __device__ __forceinline__ void done(const Unit&) const {}
};

typedef float cvt_f32x2 __attribute__((ext_vector_type(2))); typedef __bf16 cvt_bf16x2 __attribute__((ext_vector_type(2)));
__device__ __forceinline__ unsigned cvt_pk_bf16(float lo, float hi) { cvt_f32x2 v = {lo, hi}; cvt_bf16x2 b = __builtin_convertvector(v, cvt_bf16x2); return __builtin_bit_cast(unsigned, b); }
typedef float f32x2 __attribute__((ext_vector_type(2)));
__device__ __forceinline__ float sigm(float x) { return __builtin_amdgcn_rcpf(1.f + __builtin_amdgcn_exp2f(-1.4426950408889634f * x)); }
__device__ __forceinline__ f32x4 sigm4(f32x4 v) { return (f32x4){sigm(v[0]), sigm(v[1]), sigm(v[2]), sigm(v[3])}; }
__device__ __forceinline__ u32x4 pack8(f32x4 a, f32x4 b) { u32x4 w; w.x = cvt_pk_bf16(a[0], a[1]); w.y = cvt_pk_bf16(a[2], a[3]); w.z = cvt_pk_bf16(b[0], b[1]); w.w = cvt_pk_bf16(b[2], b[3]); return w; }
__device__ __forceinline__ void unpack8(u32x4 w, f32x4& a, f32x4& b) {
    a = (f32x4){__uint_as_float(w.x << 16), __uint_as_float(w.x & 0xffff0000u), __uint_as_float(w.y << 16), __uint_as_float(w.y & 0xffff0000u)};
    b = (f32x4){__uint_as_float(w.z << 16), __uint_as_float(w.z & 0xffff0000u), __uint_as_float(w.w << 16), __uint_as_float(w.w & 0xffff0000u)}; }
__device__ __forceinline__ f32x4 shx4(f32x4 v, int m) { return (f32x4){__shfl_xor(v[0], m), __shfl_xor(v[1], m), __shfl_xor(v[2], m), __shfl_xor(v[3], m)}; }
__device__ __forceinline__ float hsum4(f32x4 v) { return (v[0] + v[1]) + (v[2] + v[3]); }
__device__ __forceinline__ void st_nt(bf16_t* p, u32x4 v) { __builtin_nontemporal_store(v, (u32x4*)p); }
__device__ __forceinline__ void st_nt(float* p, f32x4 v) { __builtin_nontemporal_store(v, (f32x4*)p); }

struct EpiInProj {
    static constexpr bool PERM = true, AFTER_DRAIN = false;
    bf16_t* QKV; bf16_t* GLU; bf16_t* G; const float* gate_b; const float* qg; const float* kg; const float* cs;
    __device__ __forceinline__ void operator()(const f32x4 (&acc)[2][2][4][2], const Unit& u, int wr, int wc, int fr, int fq) const {
        const int row0 = u.pm * BM + wr * 64 + fr;
        if (u.pn < 6) {
            const bool normed = u.pn < 5;
            const float qs = (u.pn < 4) ? 0.125f * 1.4426950408889634f : 1.f;
            const float* gsrc = (u.pn < 4) ? qg : kg;
            f32x4 gv[2][2];
#pragma unroll
            for (int bj = 0; bj < 2; ++bj)
#pragma unroll
                for (int n = 0; n < 2; ++n) gv[bj][n] = *(const f32x4*)(gsrc + 32 * bj + 8 * fq + 4 * n) * qs;
            const float sgn = (fq == 0) ? -1.f : 1.f;
            const int col = u.pn * 256 + wc * 64 + 8 * fq;
#pragma unroll
            for (int ai = 0; ai < 2; ++ai)
#pragma unroll
                for (int m = 0; m < 4; ++m) {
                    const int row = row0 + ai * HALF + m * 16;
                    f32x4 v00 = acc[ai][0][m][0], v01 = acc[ai][0][m][1], v10 = acc[ai][1][m][0], v11 = acc[ai][1][m][1];
                    if (normed) {
                        float ss = hsum4(v00 * v00) + hsum4(v01 * v01) + hsum4(v10 * v10) + hsum4(v11 * v11);
                        ss += __shfl_xor(ss, 16); ss += __shfl_xor(ss, 32);
                        const float rs = __builtin_amdgcn_rsqf(ss * (1.f / 64.f) + 1e-6f);
                        v00 = v00 * rs * gv[0][0]; v01 = v01 * rs * gv[0][1]; v10 = v10 * rs * gv[1][0]; v11 = v11 * rs * gv[1][1];
                        const f32x4* t = (const f32x4*)(cs + (size_t)(row & 4095) * 16);
                        const f32x4 c0 = t[0], c1 = t[1], s0 = t[2], s1 = t[3];
                        const f32x4 p0 = shx4(v00, 16), p1 = shx4(v01, 16);
                        const f32x4 r0 = v00 * c0 + p0 * s0 * sgn, r1 = v01 * c1 + p1 * s1 * sgn;
                        if (fq < 2) { v00 = r0; v01 = r1; }
                    }
                    bf16_t* rowp = QKV + (size_t)row * 1536 + col;
                    st_nt(rowp, pack8(v00, v01));
                    st_nt(rowp + 32, pack8(v10, v11));
                }
        } else if (u.pn < 14) {
            const int col = (u.pn - 6) * 128 + wc * 32 + 8 * fq;
#pragma unroll
            for (int ai = 0; ai < 2; ++ai)
#pragma unroll
                for (int m = 0; m < 4; ++m) {
                    const int row = row0 + ai * HALF + m * 16;
                    const f32x4 a0 = acc[ai][0][m][0] * sigm4(acc[ai][1][m][0]), a1 = acc[ai][0][m][1] * sigm4(acc[ai][1][m][1]);
                    st_nt(GLU + (size_t)row * 1024 + col, pack8(a0, a1));
                }
        } else {
            const int col = (u.pn - 14) * 256 + wc * 32 + 8 * fq;
            f32x4 bv[2][2];
#pragma unroll
            for (int bj = 0; bj < 2; ++bj)
#pragma unroll
                for (int n = 0; n < 2; ++n) bv[bj][n] = *(const f32x4*)(gate_b + col + bj * HALF + 4 * n);
#pragma unroll
            for (int ai = 0; ai < 2; ++ai)
#pragma unroll
                for (int m = 0; m < 4; ++m) {
                    const int row = row0 + ai * HALF + m * 16;
#pragma unroll
                    for (int bj = 0; bj < 2; ++bj)
                        st_nt(G + (size_t)row * 2048 + col + bj * HALF, pack8(sigm4(acc[ai][bj][m][0] + bv[bj][0]), sigm4(acc[ai][bj][m][1] + bv[bj][1])));
                }
        }
    }
};
struct EpiMerge {
    static constexpr bool PERM = true, AFTER_DRAIN = false;
    const bf16_t* Gt; bf16_t* Out;
    __device__ __forceinline__ void mid(f32x4 (&acc)[2][2][4][2], const Unit& u, int wr, int wc, int fr, int fq) const {
        int z; asm volatile("v_mov_b32 %0, 0" : "=v"(z));
        const int row0 = u.pm * BM + wr * 64 + fr + z, col = u.pn * BM + wc * 32 + 8 * fq;
#pragma unroll
        for (int ai = 0; ai < 2; ++ai)
#pragma unroll
            for (int m = 0; m < 4; ++m) {
                const int row = row0 + ai * HALF + m * 16;
#pragma unroll
                for (int bj = 0; bj < 2; ++bj) {
                    const bf16_t* gp = Gt + (size_t)row * 2048 + col + bj * HALF;
                    f32x4 a0, a1, b0, b1; unpack8(*(const u32x4*)gp, a0, a1); unpack8(*(const u32x4*)(gp + 1024), b0, b1);
#pragma unroll
                    for (int e = 0; e < 4; ++e) { acc[ai][bj][m][0][e] *= a0[e] * __builtin_amdgcn_rcpf(b0[e]); acc[ai][bj][m][1][e] *= a1[e] * __builtin_amdgcn_rcpf(b1[e]); }
                }
                asm volatile("" ::: "memory");
            }
    }
    __device__ __forceinline__ void operator()(const f32x4 (&acc)[2][2][4][2], const Unit& u, int wr, int wc, int fr, int fq) const {
        const int row0 = u.pm * BM + wr * 64 + fr, col = u.pn * BM + wc * 32 + 8 * fq;
#pragma unroll
        for (int ai = 0; ai < 2; ++ai)
#pragma unroll
            for (int m = 0; m < 4; ++m) {
                const int row = row0 + ai * HALF + m * 16;
#pragma unroll
                for (int bj = 0; bj < 2; ++bj) {
                    f32x4 b0, b1; unpack8(*(const u32x4*)(Gt + (size_t)row * 2048 + 1024 + col + bj * HALF), b0, b1);
                    *(u32x4*)(Out + (size_t)row * 1024 + col + bj * HALF) = pack8(acc[ai][bj][m][0] * b0, acc[ai][bj][m][1] * b1);
                }
            }
    }
};
struct EpiX1 {
    static constexpr bool PERM = true, AFTER_DRAIN = false;
    const float* x; bf16_t* X1b; float* SS;
    __device__ __forceinline__ void operator()(const f32x4 (&acc)[2][2][4][2], const Unit& u, int wr, int wc, int fr, int fq) const {
        const int row0 = u.pm * BM + wr * 64 + fr, col = u.pn * BM + wc * 32 + 8 * fq;
#pragma unroll
        for (int ai = 0; ai < 2; ++ai)
#pragma unroll
            for (int m = 0; m < 4; ++m) {
                const int row = row0 + ai * HALF + m * 16; float ss = 0.f;
#pragma unroll
                for (int bj = 0; bj < 2; ++bj) {
                    const size_t off = (size_t)row * 1024 + col + bj * HALF;
                    const f32x4 o0 = *(const f32x4*)(x + off) + acc[ai][bj][m][0], o1 = *(const f32x4*)(x + off + 4) + acc[ai][bj][m][1];
                    *(u32x4*)(X1b + off) = pack8(o0, o1);
                    ss += hsum4(o0 * o0) + hsum4(o1 * o1);
                }
                ss += __shfl_xor(ss, 16); ss += __shfl_xor(ss, 32);
                if (fq == 0) SS[(size_t)row * 16 + u.pn * 4 + wc] = ss;
            }
    }
};
struct EpiUp {
    static constexpr bool PERM = true, AFTER_DRAIN = false;
    const float* SS; bf16_t* U;
    __device__ __forceinline__ void operator()(const f32x4 (&acc)[2][2][4][2], const Unit& u, int wr, int wc, int fr, int fq) const {
        const int row0 = u.pm * BM + wr * 64 + fr, col = u.pn * BM + wc * 32 + 8 * fq;
#pragma unroll
        for (int ai = 0; ai < 2; ++ai)
#pragma unroll
            for (int m = 0; m < 4; ++m) {
                const int row = row0 + ai * HALF + m * 16;
                float ssum = hsum4(*(const f32x4*)(SS + (size_t)row * 16 + 4 * fq));
                ssum += __shfl_xor(ssum, 16); ssum += __shfl_xor(ssum, 32);
                const float rs = __builtin_amdgcn_rsqf(ssum * (1.f / 1024.f) + 1e-6f);
#pragma unroll
                for (int bj = 0; bj < 2; ++bj) {
                    f32x4 a = acc[ai][bj][m][0] * rs, b = acc[ai][bj][m][1] * rs;
#pragma unroll
                    for (int e = 0; e < 4; ++e) { a[e] = fmaxf(a[e], 0.f); b[e] = fmaxf(b[e], 0.f); }
                    st_nt(U + (size_t)row * 4096 + col + bj * HALF, pack8(a * a, b * b));
                }
            }
    }
};
struct EpiDown {
    static constexpr bool PERM = true, AFTER_DRAIN = false;
    const bf16_t* X1b; float* out;
    __device__ __forceinline__ void operator()(const f32x4 (&acc)[2][2][4][2], const Unit& u, int wr, int wc, int fr, int fq) const {
        const int row0 = u.pm * BM + wr * 64 + fr, col = u.pn * BM + wc * 32 + 8 * fq;
#pragma unroll
        for (int ai = 0; ai < 2; ++ai)
#pragma unroll
            for (int m = 0; m < 4; ++m) {
                const int row = row0 + ai * HALF + m * 16;
#pragma unroll
                for (int bj = 0; bj < 2; ++bj) {
                    const size_t off = (size_t)row * 1024 + col + bj * HALF;
                    f32x4 r0, r1; unpack8(*(const u32x4*)(X1b + off), r0, r1);
                    st_nt(out + off, r0 + acc[ai][bj][m][0]); st_nt(out + off + 4, r1 + acc[ai][bj][m][1]);
                }
            }
    }
};

template <class Epi, class Sched, bool ALIGN_EPI = false, bool SP2 = false, int MID_T = 0>
__device__ __forceinline__ void gemm_phase(PG8_LAS unsigned char* lds, const Gemm g, const Sched& S, const Epi& E) {
    const int tid = threadIdx.x, wid = __builtin_amdgcn_readfirstlane(tid >> 6), lane = tid & 63, wr = wid >> 2, wc = wid & 3, fr = lane & 15, fq = lane >> 4;
    const int K = g.K, nt = K / BK;
    unsigned voffA[2], voffB[2];
#pragma unroll
    for (int i = 0; i < 2; ++i) { int R, C; stage_rc(tid * 16 + i * 8192, R, C); const int Rb = Epi::PERM ? ((R & ~31) + perm32(R & 31)) : R;
        voffA[i] = (unsigned)(R * K + C) * 2u; voffB[i] = (unsigned)(Rb * K + C) * 2u; }
    const size_t kstep = (size_t)(BK * 2);
    const size_t hstep = (size_t)HALF * K * 2;
    const size_t tstep = 2 * hstep;
    const unsigned ldsw = (unsigned)wid * 1024u;
    const int aoff = lds_byte(wr * 64 + fr, fq * 8), boff = lds_byte(wc * 32 + fr, fq * 8);
#define PG8_SA(b, h) (((b) * 2 + (h)) * HTB)
#define PG8_SB(b, h) ((4 + (b) * 2 + (h)) * HTB)
#define PG8_STAGE(bufoff, gbase, voff) do { _Pragma("unroll") for (int _i = 0; _i < 2; ++_i) \
        __builtin_amdgcn_global_load_lds((const unsigned*)((const char*)(gbase) + (voff)[_i]), (PG8_LAS unsigned*)(lds + (bufoff) + ldsw + _i * 8192), 16, 0, 0); } while (0)
#define PG8_LDA(dst, b, h) do { _Pragma("unroll") for (int m = 0; m < 4; ++m) _Pragma("unroll") for (int k = 0; k < 2; ++k) dst[m][k] = *(const PG8_LAS bf16x8*)(lds + PG8_SA(b, h) + aoff + m * 2048 + k * 1024); } while (0)
#define PG8_LDB(dst, b, h) do { _Pragma("unroll") for (int n = 0; n < 2; ++n) _Pragma("unroll") for (int k = 0; k < 2; ++k) dst[n][k] = *(const PG8_LAS bf16x8*)(lds + PG8_SB(b, h) + boff + n * 2048 + k * 1024); } while (0)
#define PG8_MMA(ai, bj, At, Bt) do { __builtin_amdgcn_s_setprio(1); _Pragma("unroll") for (int m = 0; m < 4; ++m) _Pragma("unroll") for (int n = 0; n < 2; ++n) _Pragma("unroll") for (int k = 0; k < 2; ++k) \
        acc[ai][bj][m][n] = __builtin_amdgcn_mfma_f32_16x16x32_bf16(Bt[n][k], At[m][k], acc[ai][bj][m][n], 0, 0, 0); __builtin_amdgcn_s_setprio(0); } while (0)
#define PG8_WAIT_V(n) asm volatile("s_waitcnt vmcnt(" #n ")" ::: "memory")
#define PG8_WAIT_L(n) asm volatile("s_waitcnt lgkmcnt(" #n ")" ::: "memory")
#define PG8_BAR __builtin_amdgcn_s_barrier()
#define PG8_SCHED __builtin_amdgcn_sched_barrier(0)
    Unit cur, nxt; int ui = 0;
    if (!S.next(0, cur)) return;
    f32x4 acc[2][2][4][2];
#pragma unroll
    for (int a = 0; a < 2; ++a)
#pragma unroll
        for (int b = 0; b < 2; ++b)
#pragma unroll
            for (int m = 0; m < 4; ++m)
#pragma unroll
                for (int n = 0; n < 2; ++n) acc[a][b][m][n] = (f32x4){0.f, 0.f, 0.f, 0.f};
    bf16x8 At[4][2], B0[2][2], B1[2][2];
    const char* cA = (const char*)g.A + (size_t)cur.pm * tstep; const char* cB = (const char*)g.Bt + (size_t)cur.pn * tstep;
    S.a_ready(cur);
    if constexpr (SP2) {
        PG8_STAGE(PG8_SB(0, 0), cB, voffB); PG8_STAGE(PG8_SB(0, 1), cB + hstep, voffB); PG8_STAGE(PG8_SA(0, 0), cA, voffA); PG8_STAGE(PG8_SA(0, 1), cA + hstep, voffA);
        if (wr == 1) PG8_BAR;
        PG8_WAIT_V(2); PG8_BAR;
        PG8_STAGE(PG8_SB(1, 0), cB + kstep, voffB); PG8_STAGE(PG8_SA(1, 0), cA + kstep, voffA); PG8_STAGE(PG8_SB(1, 1), cB + hstep + kstep, voffB);
        PG8_WAIT_V(6); PG8_BAR;
    } else {
        PG8_STAGE(PG8_SB(0, 0), cB, voffB); PG8_STAGE(PG8_SA(0, 0), cA, voffA); PG8_STAGE(PG8_SB(0, 1), cB + hstep, voffB); PG8_STAGE(PG8_SA(0, 1), cA + hstep, voffA);
        if (wr == 1) PG8_BAR;
        PG8_WAIT_V(4); PG8_BAR;
        PG8_STAGE(PG8_SB(1, 0), cB + kstep, voffB); PG8_STAGE(PG8_SA(1, 0), cA + kstep, voffA); PG8_STAGE(PG8_SB(1, 1), cB + hstep + kstep, voffB);
        PG8_WAIT_V(6); PG8_BAR;
    }
    for (;;) {
        const bool has_next = S.next(ui + 1, nxt);
        const char* nA = has_next ? (const char*)g.A + (size_t)nxt.pm * tstep : cA; const char* nB = has_next ? (const char*)g.Bt + (size_t)nxt.pn * tstep : cB;
        for (int t = 0; t < nt; t += 2) {
            const bool last = (t == nt - 2);
            if constexpr (MID_T > 0) { if (t == MID_T) E.mid(acc, cur, wr, wc, fr, fq); }
            const char* a1 = cA + (size_t)(t + 1) * kstep;
            const char* a2 = last ? nA : cA + (size_t)(t + 2) * kstep; const char* b2 = last ? nB : cB + (size_t)(t + 2) * kstep;
            const char* a3 = a2 + kstep; const char* b3 = b2 + kstep;
            if (last && has_next) S.a_ready(nxt);
            if constexpr (SP2) {
            PG8_LDB(B0, 0, 0); PG8_LDB(B1, 0, 1); PG8_SCHED; PG8_LDA(At, 0, 0); PG8_STAGE(PG8_SA(1, 1), a1 + hstep, voffA);
            PG8_WAIT_V(8); PG8_WAIT_L(0); PG8_BAR; PG8_MMA(0, 0, At, B0); PG8_MMA(0, 1, At, B1); PG8_BAR; PG8_SCHED;
            PG8_LDA(At, 0, 1); PG8_STAGE(PG8_SB(0, 0), b2, voffB); PG8_STAGE(PG8_SB(0, 1), b2 + hstep, voffB); PG8_STAGE(PG8_SA(0, 0), a2, voffA);
            PG8_WAIT_V(8); PG8_WAIT_L(0); PG8_BAR; PG8_MMA(1, 0, At, B0); PG8_MMA(1, 1, At, B1); PG8_BAR; PG8_SCHED;
            PG8_LDB(B0, 1, 0); PG8_LDB(B1, 1, 1); PG8_SCHED; PG8_LDA(At, 1, 0); PG8_STAGE(PG8_SA(0, 1), a2 + hstep, voffA);
            PG8_WAIT_V(8); PG8_WAIT_L(0); PG8_BAR; PG8_MMA(0, 0, At, B0); PG8_MMA(0, 1, At, B1); PG8_BAR; PG8_SCHED;
            PG8_LDA(At, 1, 1); PG8_STAGE(PG8_SB(1, 0), b3, voffB); PG8_STAGE(PG8_SB(1, 1), b3 + hstep, voffB); PG8_STAGE(PG8_SA(1, 0), a3, voffA);
            PG8_WAIT_V(8); PG8_WAIT_L(0); PG8_BAR; PG8_MMA(1, 0, At, B0); PG8_MMA(1, 1, At, B1); PG8_BAR; PG8_SCHED;
            } else {
            PG8_LDB(B0, 0, 0); PG8_SCHED; PG8_LDA(At, 0, 0); PG8_STAGE(PG8_SA(1, 1), a1 + hstep, voffA);
            PG8_WAIT_L(8); PG8_BAR; PG8_WAIT_L(0); PG8_MMA(0, 0, At, B0); PG8_BAR; PG8_SCHED;
            PG8_LDB(B1, 0, 1); PG8_STAGE(PG8_SB(0, 0), b2, voffB);
            PG8_BAR; PG8_WAIT_L(0); PG8_MMA(0, 1, At, B1); PG8_BAR;
            PG8_LDA(At, 0, 1); PG8_STAGE(PG8_SA(0, 0), a2, voffA);
            PG8_BAR; PG8_WAIT_L(0); PG8_MMA(1, 0, At, B0); PG8_BAR; PG8_SCHED;
            PG8_STAGE(PG8_SB(0, 1), b2 + hstep, voffB);
            PG8_WAIT_V(6); PG8_BAR; PG8_MMA(1, 1, At, B1); PG8_BAR;
            PG8_LDB(B0, 1, 0); PG8_SCHED; PG8_LDA(At, 1, 0); PG8_STAGE(PG8_SA(0, 1), a2 + hstep, voffA);
            PG8_WAIT_L(8); PG8_BAR; PG8_WAIT_L(0); PG8_MMA(0, 0, At, B0); PG8_BAR; PG8_SCHED;
            PG8_LDB(B1, 1, 1); PG8_STAGE(PG8_SB(1, 0), b3, voffB);
            PG8_BAR; PG8_WAIT_L(0); PG8_MMA(0, 1, At, B1); PG8_BAR;
            PG8_LDA(At, 1, 1); PG8_STAGE(PG8_SA(1, 0), a3, voffA);
            PG8_BAR; PG8_WAIT_L(0); PG8_MMA(1, 0, At, B0); PG8_BAR; PG8_SCHED;
            PG8_STAGE(PG8_SB(1, 1), b3 + hstep, voffB);
            PG8_WAIT_V(6); PG8_BAR; PG8_MMA(1, 1, At, B1); PG8_BAR;
            }
        }
        if constexpr (ALIGN_EPI) { if (wr == 0) PG8_BAR; }
        if constexpr (!Epi::AFTER_DRAIN) { E(acc, cur, wr, wc, fr, fq); S.done(cur); }
        if (!has_next) break;
#pragma unroll
        for (int a = 0; a < 2; ++a)
#pragma unroll
            for (int b = 0; b < 2; ++b)
#pragma unroll
                for (int m = 0; m < 4; ++m)
#pragma unroll
                    for (int n = 0; n < 2; ++n) acc[a][b][m][n] = (f32x4){0.f, 0.f, 0.f, 0.f};
        cur = nxt; cA = nA; cB = nB; ++ui;
        if constexpr (ALIGN_EPI) { if (wr == 1) PG8_BAR; }
    }
    PG8_WAIT_V(0);
    if constexpr (!ALIGN_EPI) { if (wr == 0) PG8_BAR; }
    PG8_BAR;
    if constexpr (Epi::AFTER_DRAIN) { E.fused(acc, cur, wr, wc, fr, fq, lds, wid, lane); S.done(cur); }
#undef PG8_SA
#undef PG8_SB
#undef PG8_STAGE
#undef PG8_LDA
#undef PG8_LDB
#undef PG8_MMA
#undef PG8_WAIT_V
#undef PG8_WAIT_L
#undef PG8_BAR
#undef PG8_SCHED
}
}

constexpr int NWAVES = 8;
constexpr int BATCH = 8, SEQ = 4096, D = 1024, FF = 4096, M = BATCH * SEQ, INW = 5632;
constexpr size_t MiB = 1u << 20;
constexpr size_t WS_CS = 1 * MiB;
constexpr size_t WS_WIN = 2 * MiB, WS_WCAT = 14 * MiB, WS_WOUT = 18 * MiB, WS_WUP = 20 * MiB, WS_WDN = 28 * MiB;
constexpr size_t WS_SS = 36 * MiB;
constexpr size_t WS_QKV = 40 * MiB;
constexpr size_t WS_GLU = 136 * MiB;
constexpr size_t WS_G = 200 * MiB;
constexpr size_t WS_ACAT = 328 * MiB;
constexpr size_t WS_H = 328 * MiB;
constexpr size_t WS_U = 200 * MiB;
constexpr size_t WS_END = 456 * MiB;
constexpr int RING_BYTES = 131072, LDS_BYTES = RING_BYTES + 64 + 2048;

#define GAS __attribute__((address_space(1)))
#define LAS __attribute__((address_space(3)))
typedef unsigned short bf16;
typedef unsigned v4u __attribute__((ext_vector_type(4)));
typedef unsigned v2u __attribute__((ext_vector_type(2)));
typedef float f32x4 __attribute__((ext_vector_type(4)));
typedef float f32x2 __attribute__((ext_vector_type(2)));
typedef float f32x16 __attribute__((ext_vector_type(16)));
typedef short bf16x8 __attribute__((ext_vector_type(8)));
typedef short s16x4 __attribute__((ext_vector_type(4)));
#define LDS_WAIT() asm volatile("s_waitcnt lgkmcnt(0)" ::: "memory")
__device__ __forceinline__ unsigned f2bf(float f) { unsigned u = __builtin_bit_cast(unsigned, f); return (u + 0x7fffu + ((u >> 16) & 1u)) >> 16; }
__device__ __forceinline__ unsigned pk2(float lo, float hi) { return f2bf(lo) | (f2bf(hi) << 16); }
__device__ __forceinline__ float wave_sum(float v) {
#pragma unroll
    for (int o = 1; o < 64; o <<= 1) v += __shfl_xor(v, o);
    return v;
}

__device__ __forceinline__ int win_row_map(int n0) {
    if (n0 < 1536) { const int tile = n0 >> 8, local = n0 & 255, wc = local >> 6, bj = (local >> 5) & 1; return tile * 256 + bj * 128 + wc * 32; }
    if (n0 < 3584) { const int cc = n0 - 1536, half = cc >> 10, ch = cc & 1023; return 1536 + (ch >> 7) * 256 + half * 128 + (ch & 127); }
    return n0;
}
#define W_LD(p) __builtin_nontemporal_load(p)
struct P0Item { const float* W; bf16* WT; const float* kscale; int N, ldk, k0, n0, r0; };
__device__ __forceinline__ void p0_item_load(const P0Item& t, float (&w)[32], int lane) {
#pragma unroll
    for (int i = 0; i < 32; ++i) { const int kk = 2 * i + (lane >> 5); w[i] = W_LD(t.W + (size_t)(t.k0 + kk) * t.N + t.n0 + (lane & 31)); }
}
__device__ __forceinline__ void p0_item_finish(const P0Item& t, const float (&w)[32], LAS float* scr, int lane) {
#pragma unroll
    for (int i = 0; i < 32; ++i) { const int kk = 2 * i + (lane >> 5); float v = w[i]; if (t.kscale) v *= t.kscale[t.k0 + kk]; scr[kk * 33 + (lane & 31)] = v; }
    LDS_WAIT(); asm volatile("" ::: "memory");
    const int c = lane & 7;
#pragma unroll
    for (int j = 0; j < 4; ++j) { const int n = (lane >> 3) + 8 * j; const LAS float* sp = scr + (8 * c) * 33 + n;
        v4u o; o.x = pk2(sp[0 * 33], sp[1 * 33]); o.y = pk2(sp[2 * 33], sp[3 * 33]); o.z = pk2(sp[4 * 33], sp[5 * 33]); o.w = pk2(sp[6 * 33], sp[7 * 33]);
        *(GAS v4u*)(t.WT + (size_t)(t.r0 + n) * t.ldk + t.k0 + 8 * c) = o; }
    LDS_WAIT(); asm volatile("" ::: "memory");
}
__device__ __forceinline__ void rms_rows_to_bf16(const float* xrow, const float* g, bf16* orow, int lane, size_t rstride) {
    constexpr int NR = 4;
    const f32x4* gr = (const f32x4*)g + lane;
    f32x4 v[NR][4]; float s[NR];
#pragma unroll
    for (int r = 0; r < NR; ++r) { const GAS f32x4* xr = (const GAS f32x4*)(xrow + r * rstride) + lane; s[r] = 0.f;
#pragma unroll
        for (int j = 0; j < 4; ++j) { v[r][j] = __builtin_nontemporal_load(xr + 64 * j); } }
#pragma unroll
    for (int r = 0; r < NR; ++r) {
#pragma unroll
        for (int j = 0; j < 4; ++j) s[r] += (v[r][j].x * v[r][j].x + v[r][j].y * v[r][j].y) + (v[r][j].z * v[r][j].z + v[r][j].w * v[r][j].w);
        const float rs = 1.f / sqrtf(wave_sum(s[r]) * (1.f / D) + 1e-6f);
        GAS unsigned long long* o8 = (GAS unsigned long long*)(orow + r * rstride) + lane;
#pragma unroll
        for (int j = 0; j < 4; ++j) { const f32x4 w = v[r][j] * rs * gr[64 * j]; o8[64 * j] = (unsigned long long)pk2(w.x, w.y) | ((unsigned long long)pk2(w.z, w.w) << 32); }
    }
}

namespace att {
constexpr int KP = 144, KROWS = 192, LDS_K = 0, LDS_V = KROWS * KP;
__device__ __forceinline__ int crow(int r, int hi) { return (r & 3) + 8 * (r >> 2) + 4 * hi; }
typedef float f32x2_t __attribute__((ext_vector_type(2))); typedef __bf16 bf16x2_t __attribute__((ext_vector_type(2)));
__device__ __forceinline__ unsigned cvtpk(float lo, float hi) { f32x2_t v = {lo, hi}; bf16x2_t b = __builtin_convertvector(v, bf16x2_t); return __builtin_bit_cast(unsigned, b); }
typedef short v4i16_t __attribute__((ext_vector_type(4)));
__device__ __forceinline__ s16x4 vtr(const LAS unsigned char* p) { return __builtin_bit_cast(s16x4, __builtin_amdgcn_ds_read_tr16_b64_v4i16((LAS v4i16_t*)p)); }
struct Stage { v4u r[6]; };
__device__ __forceinline__ void stage_load(Stage& st, const bf16* QKV, long tok0, int r0, int kvh, int tid) {
#pragma unroll
    for (int j = 0; j < 6; ++j) { const int cc = tid + 512 * (j % 3), row = cc >> 3, ch = cc & 7; int kpos = r0 - 128 + row; kpos = kpos < 0 ? 0 : kpos;
        st.r[j] = *(const GAS v4u*)(QKV + (size_t)(tok0 + kpos) * 1536 + 1024 + (j / 3) * 256 + kvh * 64 + ch * 8); }
}
__device__ __forceinline__ void stage_store(const Stage& st, LAS unsigned char* lds, int tid) {
#pragma unroll
    for (int j = 0; j < 6; ++j) { const int cc = tid + 512 * (j % 3), row = cc >> 3, ch = cc & 7; *(LAS v4u*)(lds + (j / 3) * LDS_V + row * KP + ch * 16) = st.r[j]; }
}
__device__ __forceinline__ void unit_compute(const LAS unsigned char* lds, const bf16* QKV, bf16* O, const float* sinks, long tok0, int r0, int kvh, int wid, int lane) {
    const int r = lane & 31, h = lane >> 5;
    const int head = kvh * 4 + (wid >> 1), sub = wid & 1, w0 = r0 + 32 * sub, koff = 32 * sub;
    const bf16* qp = QKV + (size_t)(tok0 + w0 + r) * 1536 + head * 64 + 8 * h;
    bf16x8 qr[4];
#pragma unroll
    for (int ds = 0; ds < 4; ++ds) qr[ds] = *(const GAS bf16x8*)(qp + 16 * ds);
    f32x16 S[5];
#pragma unroll
    for (int kb = 0; kb < 5; ++kb) {
        f32x16 a = {};
#pragma unroll
        for (int ds = 0; ds < 4; ++ds) { const bf16x8 kf = *(const LAS bf16x8*)(lds + LDS_K + (koff + 32 * kb + r) * KP + (16 * ds + 8 * h) * 2); a = __builtin_amdgcn_mfma_f32_32x32x16_bf16(kf, qr[ds], a, 0, 0, 0); }
        S[kb] = a; __builtin_amdgcn_sched_barrier(0);
    }
    const float NEG = -INFINITY;
    const int rh = r - 4 * h;
#pragma unroll
    for (int i = 0; i < 16; ++i) { const int ci = (i & 3) + 8 * (i >> 2); if (ci <= rh) S[0][i] = NEG; if (ci > rh) S[4][i] = NEG; }
    if (w0 < 128) { const int limh = 128 - w0 - 4 * h;
#pragma unroll
        for (int kb = 0; kb < 4; ++kb)
#pragma unroll
            for (int i = 0; i < 16; ++i) if (32 * kb + (i & 3) + 8 * (i >> 2) < limh) S[kb][i] = NEG; }
    const float sk = sinks[head] * 1.4426950408889634f;
    float mx = sk;
#pragma unroll
    for (int kb = 0; kb < 5; ++kb)
#pragma unroll
        for (int i = 0; i < 16; ++i) mx = fmaxf(mx, S[kb][i]);
    mx = fmaxf(mx, __shfl_xor(mx, 32));
    float l = 0.f;
#pragma unroll
    for (int kb = 0; kb < 5; ++kb)
#pragma unroll
        for (int i = 0; i < 16; ++i) { const float p = __builtin_amdgcn_exp2f(S[kb][i] - mx); S[kb][i] = p; l += p; }
    l += __shfl_xor(l, 32); l += __builtin_amdgcn_exp2f(sk - mx);
    const float inv = 1.f / l;
    f32x16 o0 = {}, o1 = {};
    const int i16 = lane & 15, q_ = i16 >> 2, p_ = i16 & 3, blk = (lane >> 4) & 1;
    const LAS unsigned char* vb = lds + LDS_V + (koff + 4 * h + q_) * KP + 32 * blk + 8 * p_;
#pragma unroll
    for (int kb = 0; kb < 5; ++kb)
#pragma unroll
        for (int s = 0; s < 2; ++s) {
            v4u pw;
#pragma unroll
            for (int e = 0; e < 4; ++e) pw[e] = cvtpk(S[kb][8 * s + 2 * e], S[kb][8 * s + 2 * e + 1]);
            const bf16x8 pa = __builtin_bit_cast(bf16x8, pw);
            const LAS unsigned char* vp = vb + (32 * kb + 16 * s) * KP;
            const s16x4 lo0 = vtr(vp), hi0 = vtr(vp + 8 * KP), lo1 = vtr(vp + 64), hi1 = vtr(vp + 8 * KP + 64);
            const bf16x8 v0 = __builtin_shufflevector(lo0, hi0, 0, 1, 2, 3, 4, 5, 6, 7), v1 = __builtin_shufflevector(lo1, hi1, 0, 1, 2, 3, 4, 5, 6, 7);
            o0 = __builtin_amdgcn_mfma_f32_32x32x16_bf16(v0, pa, o0, 0, 0, 0);
            o1 = __builtin_amdgcn_mfma_f32_32x32x16_bf16(v1, pa, o1, 0, 0, 0);
            __builtin_amdgcn_sched_barrier(0);
        }
    bf16* op = O + (size_t)(tok0 + w0 + r) * 2048 + head * 64 + 8 * h;
#pragma unroll
    for (int dh = 0; dh < 2; ++dh)
#pragma unroll
        for (int g = 0; g < 4; g += 2) {
            const f32x16& o = dh ? o1 : o0;
            const unsigned a0 = cvtpk(o[4 * g] * inv, o[4 * g + 1] * inv), a1 = cvtpk(o[4 * g + 2] * inv, o[4 * g + 3] * inv);
            const unsigned b0 = cvtpk(o[4 * g + 4] * inv, o[4 * g + 5] * inv), b1 = cvtpk(o[4 * g + 6] * inv, o[4 * g + 7] * inv);
            const auto s0 = __builtin_amdgcn_permlane32_swap(a0, b0, false, false), s1 = __builtin_amdgcn_permlane32_swap(a1, b1, false, false);
            const v4u w = {s0[0], s1[0], s0[1], s1[1]};
            *(GAS v4u*)(op + 32 * dh + 8 * g) = w;
        }
}
}

constexpr int CONV_PART_OFF = 131072 + 64;
__device__ __forceinline__ void conv_dma_rows(LAS unsigned char* lds, const bf16* GLU, int c0, int kb, int ke, int wid, int lane) {
    for (int p = 2 * kb + wid; p < 2 * ke; p += 8) {
        const int k = p >> 1, half = p & 1, grow = c0 - 30 + k;
        if (grow >= 0) __builtin_amdgcn_global_load_lds((const unsigned*)(GLU + (size_t)grow * 1024 + half * 512 + lane * 8), (LAS unsigned*)(lds + (k & 63) * 2048 + half * 1024), 16, 0, 0);
    }
}
template <int I> __device__ __forceinline__ void conv_steps(f32x2 (&acc)[32], const f32x2 (&w)[31], const LAS unsigned char* b0, const LAS unsigned char* b1, bool zero_head) {
    unsigned u = *(const LAS unsigned*)((I < 32 ? b0 : b1) + (I & 31) * 2048);
    if (I < 30) u = zero_head ? 0u : u;
    const f32x2 xv = {__uint_as_float(u << 16), __uint_as_float(u & 0xffff0000u)};
#pragma unroll
    for (int o = 0; o < 32; ++o) { if (I - o >= 0 && I - o <= 30) { const f32x2 wj = w[(I - o >= 0 && I - o <= 30) ? I - o : 0];
        asm("v_fmac_f32 %0, %1, %2" : "+v"(acc[o].x) : "v"(wj.x), "v"(xv.x)); asm("v_fmac_f32 %0, %1, %2" : "+v"(acc[o].y) : "v"(wj.y), "v"(xv.y)); } }
    if ((I & 15) == 15) __builtin_amdgcn_sched_barrier(0);
    if constexpr (I + 1 < 62) conv_steps<I + 1>(acc, w, b0, b1, zero_head);
}
#define CONV_BFLY(n) do { const bool up_ = (lane & (n)) != 0; _Pragma("unroll") for (int i_ = 0; i_ < (n); ++i_) { const float a_ = v[i_], b_ = v[i_ + (n)]; \
        const float send_ = up_ ? a_ : b_, keep_ = up_ ? b_ : a_; v[i_] = keep_ + __shfl_xor(send_, (n)); } } while (0)
__device__ __forceinline__ void conv_chunk(LAS unsigned char* lds, const bf16* GLU, bf16* C, const float* cw, const float* cb, const float* ng, const float* nb, int c0, int nunits, int tid, int wid, int lane) {
    f32x2 w[31];
#pragma unroll
    for (int j = 0; j < 31; ++j) w[j] = *(const f32x2*)(cw + j * 1024 + 2 * tid);
    const f32x2 bias = *(const f32x2*)(cb + 2 * tid), g2 = *(const f32x2*)(ng + 2 * tid), b2 = *(const f32x2*)(nb + 2 * tid);
    const LAS unsigned char* bA = lds + tid * 4; const LAS unsigned char* bB = bA + 65536;
    LAS float* part = (LAS float*)(lds + CONV_PART_OFF);
    conv_dma_rows(lds, GLU, c0, 0, 62, wid, lane);
    for (int j = 0; j < nunits; ++j) {
        const int t0 = c0 + 32 * j;
        asm volatile("s_waitcnt vmcnt(0)" ::: "memory"); __syncthreads();
        f32x2 acc[32];
#pragma unroll
        for (int o = 0; o < 32; ++o) acc[o] = bias;
        const bool par = (j & 1) != 0;
        conv_steps<0>(acc, w, par ? bB : bA, par ? bA : bB, (t0 & (SEQ - 1)) == 0);
        __syncthreads();
        if (j + 1 < nunits) conv_dma_rows(lds, GLU, c0, 62 + 32 * j, 94 + 32 * j, wid, lane);
        float v[64];
#pragma unroll
        for (int o = 0; o < 32; ++o) { v[o] = acc[o].x + acc[o].y; v[32 + o] = acc[o].x * acc[o].x + acc[o].y * acc[o].y; }
        CONV_BFLY(32); CONV_BFLY(16); CONV_BFLY(8); CONV_BFLY(4); CONV_BFLY(2); CONV_BFLY(1);
        part[wid * 64 + lane] = v[0];
        __syncthreads();
        float tot = 0.f;
#pragma unroll
        for (int ww = 0; ww < 8; ++ww) tot += part[ww * 64 + lane];
        const float sq = __shfl_xor(tot, 32);
        const float mean = tot * (1.f / 1024.f), var = fmaxf(sq * (1.f / 1024.f) - mean * mean, 0.f), rstd = __builtin_amdgcn_rsqf(var + 1e-6f);
        GAS unsigned* cp = (GAS unsigned*)(C + (size_t)t0 * 2048) + tid;
#pragma unroll
        for (int o = 0; o < 32; ++o) {
            const float m = __builtin_bit_cast(float, __builtin_amdgcn_readlane(__builtin_bit_cast(int, mean), o)), r = __builtin_bit_cast(float, __builtin_amdgcn_readlane(__builtin_bit_cast(int, rstd), o));
            f32x2 z = (acc[o] - m) * r * g2 + b2; z.x = z.x * pg8::sigm(z.x); z.y = z.y * pg8::sigm(z.y);
            __builtin_nontemporal_store(pg8::cvt_pk_bf16(z.x, z.y), cp + (size_t)o * 1024);
        }
    }
    __syncthreads();
}

#define XB_TMO      128
#define XB_XCNT(j)  (256  + 64 * (j))
#define XB_XSUB(j)  (1280 + 64 * (j))
#define XB_XGEN(j)  (2304 + 64 * (j))
#define XB_TOP      3328
#define XB_TOPGEN   3392
#define XCD_BAR_WORDS 3456
#define XB_SPIN_CAP (1u << 18)

__device__ __forceinline__ unsigned xb_ld(unsigned* p)              { return __hip_atomic_load(p, __ATOMIC_RELAXED, __HIP_MEMORY_SCOPE_AGENT); }
__device__ __forceinline__ unsigned xb_add(unsigned* p, unsigned v) { return __hip_atomic_fetch_add(p, v, __ATOMIC_RELAXED, __HIP_MEMORY_SCOPE_AGENT); }
__device__ __forceinline__ unsigned xb_xcc_id() { return (unsigned)__builtin_amdgcn_s_getreg((3 << 11) | 20) & 0xFu; }
#define XB_SPIN(cond, bar) do { unsigned _sp = 0; while (cond) { __builtin_amdgcn_s_sleep(1); \
    if ((++_sp & 255u) == 0u) { if (xb_ld(&(bar)[XB_TMO])) break; if (_sp > XB_SPIN_CAP) { atomicAdd(&(bar)[XB_TMO], 1u); break; } } } } while (0)

struct XcdBarrier {
    unsigned* bar; unsigned x;
    volatile LAS unsigned* st;
};

__device__ __forceinline__ XcdBarrier xcd_barrier_post(unsigned* bar, volatile LAS unsigned* st) {
    XcdBarrier b; b.bar = bar; b.x = xb_xcc_id(); b.st = st;
    if (threadIdx.x == 0) (void)xb_add(&bar[XB_XCNT(b.x)], 1u);
    return b;
}
__device__ __forceinline__ void xcd_barrier_complete(unsigned* bar, unsigned x, unsigned& nloc, unsigned& nx) {
    const unsigned G = gridDim.x * gridDim.y * gridDim.z;
    unsigned sum, cnt, mine, sp = 0u;
    for (;;) {
        sum = 0u; cnt = 0u; mine = 0u;
#pragma unroll
        for (unsigned j = 0; j < 16; ++j) { const unsigned c = xb_ld(&bar[XB_XCNT(j)]); sum += c; cnt += (c > 0u) ? 1u : 0u; mine = (j == x) ? c : mine; }
        if (sum == G) break;
        __builtin_amdgcn_s_sleep(1);
        if ((++sp & 255u) == 0u) { if (xb_ld(&bar[XB_TMO])) break; if (sp > XB_SPIN_CAP) { atomicAdd(&bar[XB_TMO], 1u); break; } }
    }
    nloc = mine > 0u ? mine : 1u; nx = cnt > 0u ? cnt : 1u;
}

__device__ __forceinline__ void xcd_barrier(const XcdBarrier& b) {
    asm volatile("s_waitcnt vmcnt(0)" ::: "memory");
    __syncthreads();
    if (threadIdx.x == 0) {
        unsigned* bar = b.bar;
        __builtin_amdgcn_s_waitcnt(0);
        unsigned nloc = b.st[0], nx = b.st[1];
        if (nloc == 0u) { xcd_barrier_complete(bar, b.x, nloc, nx); b.st[0] = nloc; b.st[1] = nx; }
        const unsigned old = xb_add(&bar[XB_XSUB(b.x)], 1u);
        const unsigned gen = old / nloc;
        if (old + 1u == (gen + 1u) * nloc) {
            __builtin_amdgcn_fence(__ATOMIC_RELEASE, "agent");
            asm volatile("s_waitcnt vmcnt(0)" ::: "memory");
            const unsigned og = xb_add(&bar[XB_TOP], 1u);
            const unsigned tg = og / nx;
            if (og + 1u == (tg + 1u) * nx) xb_add(&bar[XB_TOPGEN], 1u);
            else XB_SPIN(xb_ld(&bar[XB_TOPGEN]) == tg, bar);
            __builtin_amdgcn_fence(__ATOMIC_ACQUIRE, "agent");
            xb_add(&bar[XB_XGEN(b.x)], 1u);
            asm volatile("s_waitcnt vmcnt(0)" ::: "memory");
        } else {
            XB_SPIN(xb_ld(&bar[XB_XGEN(b.x)]) == gen, bar);
            __builtin_amdgcn_fence(__ATOMIC_ACQUIRE, "agent");
            asm volatile("s_waitcnt vmcnt(0)" ::: "memory");
        }
    }
    __syncthreads();
}

#ifndef ATT_REP
#define ATT_REP 1
#endif
#ifndef CONV_REP
#define CONV_REP 1
#endif
#ifndef WGM_P1
#define WGM_P1 4
#endif
#ifndef WGM_P5
#define WGM_P5 4
#endif
#ifndef MK_N_LAUNCHES
#define MK_N_LAUNCHES 1
#endif
constexpr int N_PHASES = 7;
struct Args { const float* in[17]; float* out; unsigned char* ws; int ph_lo, ph_hi; };
static_assert(sizeof(Args) == 17 * 8 + 8 + 8 + 8, "Args has no padding");

__global__ void __launch_bounds__(NWAVES * 64, 2) mega_fwd(Args args) {
    extern __shared__ __attribute__((aligned(16))) unsigned char lds_raw[];
    LAS unsigned char* lds = (LAS unsigned char*)lds_raw;
    const int tid = threadIdx.x, lane = tid & 63, wid = __builtin_amdgcn_readfirstlane(tid >> 6);
    const int G = gridDim.x, bx = blockIdx.x;
    const int vcu = (G % 8 == 0) ? (bx % 8) * (G / 8) + bx / 8 : bx;
    volatile LAS unsigned* xst = (volatile LAS unsigned*)(lds + RING_BYTES);
    if (tid < 16) xst[tid] = 0u;
    __syncthreads();
    XcdBarrier xbar; xbar.bar = (unsigned*)args.ws; xbar.x = 0; xbar.st = xst;
    if (args.ph_hi - args.ph_lo > 1) xbar = xcd_barrier_post((unsigned*)args.ws, xst);
#define ws (args.ws)
#define x (args.in[0])
#define norm1_g (args.in[1])
#define w_in (args.in[2])
#define gate_b (args.in[3])
#define q_norm_g (args.in[4])
#define k_norm_g (args.in[5])
#define sinks (args.in[6])
#define w_attn_out (args.in[7])
#define conv_w (args.in[8])
#define conv_b (args.in[9])
#define conv_norm_g (args.in[10])
#define conv_norm_b (args.in[11])
#define w_conv_out (args.in[12])
#define w_out (args.in[13])
#define norm2_g (args.in[14])
#define w_up (args.in[15])
#define w_down (args.in[16])
#define out (args.out)
#define CS ((float*)(ws + WS_CS))
#define SS ((float*)(ws + WS_SS))
#define Win_t ((bf16*)(ws + WS_WIN))
#define Wcat_t ((bf16*)(ws + WS_WCAT))
#define Wout_t ((bf16*)(ws + WS_WOUT))
#define Wup_t ((bf16*)(ws + WS_WUP))
#define Wdn_t ((bf16*)(ws + WS_WDN))
#define Hb ((bf16*)(ws + WS_H))
#define X1b ((bf16*)(ws + WS_GLU))
#define QKV ((bf16*)(ws + WS_QKV))
#define GLU ((bf16*)(ws + WS_GLU))
#define MRG ((bf16*)(ws + WS_QKV))
#define Gb ((bf16*)(ws + WS_G))
#define ACAT ((bf16*)(ws + WS_ACAT))
#define Ub ((bf16*)(ws + WS_U))
    const int lo = args.ph_lo, hi = args.ph_hi;
#ifndef PH_MASK
#define PH_MASK 0x7f
#endif
#define IN(k) (((PH_MASK >> (k)) & 1) && lo <= (k) && (k) < hi)
#ifndef REP_MASK
#define REP_MASK 0
#endif
#define REPS(k) (((REP_MASK >> (k)) & 1) ? 2 : 1)
#define SEAM(k) do { if (IN(k) && IN((k) + 1)) xcd_barrier(xbar); } while (0)

    if (IN(0)) for (int rep_ = 0; rep_ < REPS(0); ++rep_) {
        LAS float* scr = (LAS float*)(lds + wid * 16384);
        const int gw = vcu * NWAVES + wid, NGW = G * NWAVES;
        constexpr int I_IN = (D / 64) * (INW / 32), I_SQ = (D / 64) * (D / 32), I_UP = (D / 64) * (FF / 32), I_DN = (FF / 64) * (D / 32);
        constexpr int NITEMS = I_IN + 3 * I_SQ + I_UP + I_DN;
        auto decode = [&](int it) -> P0Item {
            P0Item t; int r = it; const float* W; bf16* WT; const float* ks = nullptr; int K, N, ldk; bool map_in = false;
            if (r < I_IN) { W = w_in; WT = Win_t; K = D; N = INW; ldk = D; map_in = true; }
            else if ((r -= I_IN) < I_SQ) { W = w_attn_out; WT = Wcat_t; K = D; N = D; ldk = 2 * D; }
            else if ((r -= I_SQ) < I_SQ) { W = w_conv_out; WT = Wcat_t + D; K = D; N = D; ldk = 2 * D; }
            else if ((r -= I_SQ) < I_SQ) { W = w_out; WT = Wout_t; K = D; N = D; ldk = D; }
            else if ((r -= I_SQ) < I_UP) { W = w_up; WT = Wup_t; K = D; N = FF; ldk = D; ks = norm2_g; }
            else { r -= I_UP; W = w_down; WT = Wdn_t; K = FF; N = D; ldk = FF; }
            (void)K; const int nblk = N / 32, kb = r / nblk, nb = r % nblk;
            t.W = W; t.WT = WT; t.kscale = ks; t.N = N; t.ldk = ldk; t.k0 = 64 * kb; t.n0 = 32 * nb; t.r0 = map_in ? win_row_map(t.n0) : t.n0;
            return t;
        };
        if (gw < NITEMS) {
            float w0[32], w1[32], w2[32]; P0Item t0 = decode(gw), t1 = t0, t2 = t0;
            p0_item_load(t0, w0, lane);
            if (gw + NGW < NITEMS) { t1 = decode(gw + NGW); p0_item_load(t1, w1, lane); }
            for (int it = gw; it < NITEMS; it += NGW) {
                if (it + 2 * NGW < NITEMS) { t2 = decode(it + 2 * NGW); p0_item_load(t2, w2, lane); }
                p0_item_finish(t0, w0, scr, lane);
                t0 = t1; t1 = t2;
#pragma unroll
                for (int i = 0; i < 32; ++i) { w0[i] = w1[i]; w1[i] = w2[i]; }
            }
        }
        for (int m = gw; m < M / 4; m += NGW) rms_rows_to_bf16(x + (size_t)m * D, norm1_g, Hb + (size_t)m * D, lane, (size_t)(M / 4) * D);
        for (int id = bx * (NWAVES * 64) + tid; id < SEQ * 8; id += G * NWAVES * 64) {
            const int pos = id >> 3, i = id & 7;
            const float invf = (i == 0) ? 1.0f : (i == 1) ? 0.193922758102417f : (i == 2) ? 0.03760603070259094f : (i == 3) ? 0.00729266507551074f : (i == 4) ? 0.001414213445968926f
                             : (i == 5) ? 0.00027424818836152554f : (i == 6) ? 5.318296462064609e-05f : 1.0313385246263351e-05f;
            const float ang = (float)pos * invf;
            double rev = (double)ang * 0.15915494309189533577; rev -= __builtin_rint(rev);
            CS[pos * 16 + i] = __builtin_amdgcn_cosf((float)rev); CS[pos * 16 + 8 + i] = __builtin_amdgcn_sinf((float)rev);
        }
    }
    SEAM(0);
    if (IN(1)) for (int rep_ = 0; rep_ < REPS(1); ++rep_) {
        pg8::Gemm g{Hb, Win_t, M, INW, D}; pg8::StaticOrder S; S.init(M, INW, G, bx, WGM_P1);
        pg8::EpiInProj E{QKV, GLU, Gb, gate_b, q_norm_g, k_norm_g, CS};
        pg8::gemm_phase<pg8::EpiInProj, pg8::StaticOrder, true, true>(lds, g, S, E);
    }
    SEAM(1);
    if (IN(2)) for (int rep_ = 0; rep_ < REPS(2); ++rep_) {
#ifndef NO_ATT
        {
            constexpr int NU = BATCH * 4 * (SEQ / 64);
            const int per = (NU + G - 1) / G, u0 = vcu * per, u1 = (u0 + per < NU) ? u0 + per : NU;
            att::Stage st;
            const int nu = u1 - u0, ntot = nu * ATT_REP;
            if (nu > 0) att::stage_load(st, QKV, (long)(u0 >> 8) * SEQ, (u0 & 63) * 64, (u0 >> 6) & 3, tid);
            for (int i = 0; i < ntot; ++i) {
                const int u = u0 + (ATT_REP > 1 ? i % nu : i);
                __syncthreads();
                att::stage_store(st, lds, tid);
                __syncthreads();
                if (i + 1 < ntot) { const int un = u0 + (ATT_REP > 1 ? (i + 1) % nu : i + 1); att::stage_load(st, QKV, (long)(un >> 8) * SEQ, (un & 63) * 64, (un >> 6) & 3, tid); }
                att::unit_compute(lds, QKV, ACAT, sinks, (long)(u >> 8) * SEQ, (u & 63) * 64, (u >> 6) & 3, wid, lane);
            }
        }
#endif
#ifndef NO_CONV
        {
            constexpr int NU = M / 32;
            const int per = (NU + G - 1) / G, u0 = vcu * per, u1 = (u0 + per < NU) ? u0 + per : NU;
            asm volatile("s_waitcnt vmcnt(0) lgkmcnt(0)" ::: "memory"); __syncthreads();
            if (u0 < u1) conv_chunk(lds, GLU, ACAT + 1024, conv_w, conv_b, conv_norm_g, conv_norm_b, u0 * 32, u1 - u0, tid, wid, lane);
        }
#endif
        __syncthreads();
    }
    SEAM(2);
    if (IN(3)) for (int rep_ = 0; rep_ < REPS(3); ++rep_) {
        pg8::Gemm g{ACAT, Wcat_t, M, D, 2 * D}; pg8::StaticOrder S; S.init(M, D, G, bx);
        pg8::EpiMerge E{Gb, MRG};
        pg8::gemm_phase<pg8::EpiMerge, pg8::StaticOrder, true, true, 16>(lds, g, S, E);
    }
    SEAM(3);
    if (IN(4)) for (int rep_ = 0; rep_ < REPS(4); ++rep_) {
        pg8::Gemm g{MRG, Wout_t, M, D, D}; pg8::StaticOrder S; S.init(M, D, G, bx);
        pg8::EpiX1 E{x, X1b, SS};
        pg8::gemm_phase<pg8::EpiX1, pg8::StaticOrder, true, true>(lds, g, S, E);
    }
    SEAM(4);
    if (IN(5)) for (int rep_ = 0; rep_ < REPS(5); ++rep_) {
        pg8::Gemm g{X1b, Wup_t, M, FF, D}; pg8::StaticOrder S; S.init(M, FF, G, bx, WGM_P5);
        pg8::EpiUp E{SS, Ub};
        pg8::gemm_phase<pg8::EpiUp, pg8::StaticOrder, true, true>(lds, g, S, E);
    }
    SEAM(5);
    if (IN(6)) for (int rep_ = 0; rep_ < REPS(6); ++rep_) {
        pg8::Gemm g{Ub, Wdn_t, M, D, FF}; pg8::StaticOrder S; S.init(M, D, G, bx);
        pg8::EpiDown E{X1b, out};
        pg8::gemm_phase<pg8::EpiDown, pg8::StaticOrder, true, true>(lds, g, S, E);
    }
#ifdef DBG_LAST
    if (lo == DBG_LAST) {
        const bf16* src = (const bf16*)(ws + DBG_OFF);
        for (size_t i = (size_t)bx * 512 + tid; i < (size_t)M * 1024; i += (size_t)G * 512) { const size_t m = i >> 10, c = i & 1023; out[i] = (m < (size_t)DBG_ROWS) ? __uint_as_float((unsigned)src[m * DBG_PITCH + DBG_COL + c] << 16) : 0.f; }
    }
#endif
#undef IN
#undef SEAM
#undef ws
#undef x
#undef norm1_g
#undef w_in
#undef gate_b
#undef q_norm_g
#undef k_norm_g
#undef sinks
#undef w_attn_out
#undef conv_w
#undef conv_b
#undef conv_norm_g
#undef conv_norm_b
#undef w_conv_out
#undef w_out
#undef norm2_g
#undef w_up
#undef w_down
#undef out
}

extern "C" void kernel_launch(void* const* d_in, const int* in_sizes, int n_in, void* d_out, int out_size, void* d_ws, size_t ws_size, hipStream_t stream) {
    static int grid = 0;
    if (grid == 0) {
        if (n_in != 17 || in_sizes[0] != M * D || out_size != M * D || ws_size < WS_END) { fprintf(stderr, "kernel_launch: unexpected shapes (n_in %d, in0 %d, out %d, ws %zu); nothing launched\n", n_in, n_in > 0 ? in_sizes[0] : -1, out_size, ws_size); grid = -1; return; }
        int dev = 0, cus = 0, per_cu = 0;
        if (hipGetDevice(&dev) != hipSuccess || hipDeviceGetAttribute(&cus, hipDeviceAttributeMultiprocessorCount, dev) != hipSuccess) { grid = -1; return; }
        if (hipFuncSetAttribute((const void*)mega_fwd, hipFuncAttributeMaxDynamicSharedMemorySize, LDS_BYTES) != hipSuccess) { fprintf(stderr, "kernel_launch: hipFuncSetAttribute failed\n"); grid = -1; return; }
        if (hipOccupancyMaxActiveBlocksPerMultiprocessor(&per_cu, (const void*)mega_fwd, NWAVES * 64, LDS_BYTES) != hipSuccess || per_cu < 1) { fprintf(stderr, "kernel_launch: occupancy query says %d blocks per CU\n", per_cu); per_cu = 1; }
        (void)hipGetLastError();
        grid = cus * (per_cu > 1 ? 1 : per_cu);
    }
    if (grid < 0) return;
    if (hipMemsetAsync(d_ws, 0, 16384, stream) != hipSuccess) { fprintf(stderr, "kernel_launch: hipMemsetAsync failed\n"); return; }
    Args a{};
    for (int i = 0; i < 17; ++i) a.in[i] = (const float*)d_in[i];
    a.out = (float*)d_out; a.ws = (unsigned char*)d_ws;
#if MK_N_LAUNCHES == 1
    a.ph_lo = 0; a.ph_hi = N_PHASES;
    void* kargs[] = {&a};
    hipError_t e = hipLaunchCooperativeKernel((const void*)mega_fwd, dim3(grid), dim3(NWAVES * 64), kargs, LDS_BYTES, stream);
    if (e != hipSuccess) fprintf(stderr, "kernel_launch: cooperative launch failed: %s (grid %d)\n", hipGetErrorString(e), grid);
#else
#ifdef DBG_LAST
    for (int p = 0; p <= DBG_LAST; ++p) { a.ph_lo = p; a.ph_hi = p + 1; hipLaunchKernelGGL(mega_fwd, dim3(grid), dim3(NWAVES * 64), LDS_BYTES, stream, a); }
#else
#ifndef DUP_PHASE
#define DUP_PHASE -1
#endif
    for (int p = 0; p < N_PHASES; ++p) { a.ph_lo = p; a.ph_hi = p + 1; hipLaunchKernelGGL(mega_fwd, dim3(grid), dim3(NWAVES * 64), LDS_BYTES, stream, a);
        if (p == DUP_PHASE) hipLaunchKernelGGL(mega_fwd, dim3(grid), dim3(NWAVES * 64), LDS_BYTES, stream, a); }
#endif
#endif
}
```
